# Optimizing an MI355X kernel written in HIP

```python
import math
import jax
import jax.numpy as jnp
from jax import lax
import numpy as np

D_MODEL = 1024
BATCH = 16
SEQ = 2048
DEPTH = 1

CTX_LEN = 256
GRID_W = 64
N_HEADS = 8
HEAD_DIM = 64
V_DIM = 2 * HEAD_DIM
QK_WIDTH = N_HEADS * 2 * HEAD_DIM
ATTN_WIDTH = N_HEADS * V_DIM
POOL_WINDOWS = (2, 4, 8, 16)
POOL_GROUPS = len(POOL_WINDOWS)
POOL_GROUP_DIM = 128
POOL_WIDTH = POOL_GROUPS * POOL_GROUP_DIM
N_BRANCH = 2
D_FF = 2816
ROPE_BASE = 10000.0
ROPE_AXIS_DIM = HEAD_DIM // 2
Q_BLOCK = 128
N_MOD = 9
EPS = 1e-6

Q_OFF = 0
K_OFF = Q_OFF + QK_WIDTH
V_OFF = K_OFF + QK_WIDTH
P_OFF = V_OFF + ATTN_WIDTH
G_OFF = P_OFF + POOL_WIDTH
IN_COLS = G_OFF + N_BRANCH * D_MODEL

kernel_name = "hybrid_diffattn_pool_macaron_dit"


def rms_norm(x, g):
    xf = x.astype(jnp.float32)
    y = xf * lax.rsqrt(jnp.mean(xf * xf, axis=-1, keepdims=True) + EPS)
    return (y * g.astype(jnp.float32)).astype(x.dtype)


def modulate(h, shift, scale):
    return h * (1 + scale) + shift


def swiglu(h, w_gu, w_down):
    a, b = jnp.split(h @ w_gu, 2, axis=-1)
    return (jax.nn.silu(a) * b) @ w_down


def rope_1d(x, pos):
    half = ROPE_AXIS_DIM // 2
    freqs = ROPE_BASE ** (-jnp.arange(half, dtype=jnp.float32) / half)
    ang = pos.astype(jnp.float32)[:, None] * freqs[None, :]
    cos = jnp.cos(ang)[None, :, None, None, :].astype(x.dtype)
    sin = jnp.sin(ang)[None, :, None, None, :].astype(x.dtype)
    x1, x2 = x[..., :half], x[..., half:]
    return jnp.concatenate([x1 * cos - x2 * sin, x2 * cos + x1 * sin], axis=-1)


def rope_2d(x, row_ids, col_ids):
    return jnp.concatenate([rope_1d(x[..., :ROPE_AXIS_DIM], row_ids),
                            rope_1d(x[..., ROPE_AXIS_DIM:], col_ids)], axis=-1)


def split_qk(z):
    return z.reshape(z.shape[0], z.shape[1], N_HEADS, 2, HEAD_DIM)


def split_v(z):
    return z.reshape(z.shape[0], z.shape[1], N_HEADS, V_DIM)


def diff_attn_block(q, k, v, lam):
    s = jnp.einsum("bqhcd,bkhcd->bhcqk", q, k).astype(jnp.float32) * (HEAD_DIM ** -0.5)
    p = jax.nn.softmax(s, axis=-1)
    p = p[:, :, 0] - lam * p[:, :, 1]
    return jnp.einsum("bhqk,bkhe->bqhe", p.astype(v.dtype), v)


def diff_attn_post(o, g_subln, lam_init):
    b, l = o.shape[0], o.shape[1]
    return (rms_norm(o, g_subln) * (1.0 - lam_init)).reshape(b, l, ATTN_WIDTH)


def pool_mix(u, w_pool, pool_scale):
    b, l, _ = u.shape
    t = jnp.arange(l)
    outs = []
    for g, w in enumerate(POOL_WINDOWS):
        ug = u[..., g * POOL_GROUP_DIM:(g + 1) * POOL_GROUP_DIM].astype(jnp.float32)
        cs = jnp.concatenate([jnp.zeros((b, 1, POOL_GROUP_DIM), jnp.float32),
                              jnp.cumsum(ug, axis=1)], axis=1)
        lo = jnp.clip(t - w // 2, 0, l)
        hi = jnp.clip(t + w - w // 2, 0, l)
        mean = (cs[:, hi] - cs[:, lo]) / (hi - lo).astype(jnp.float32)[None, :, None]
        pooled = (mean - ug).astype(u.dtype)
        outs.append(pooled @ w_pool[g])
    return jnp.concatenate(outs, axis=-1) * pool_scale


def branch_merge(attn, pool, gates, w_branch_attn, w_branch_pool, w_out):
    g_attn, g_pool = jnp.split(gates, N_BRANCH, axis=-1)
    y = jax.nn.sigmoid(g_attn) * (attn @ w_branch_attn) + jax.nn.sigmoid(g_pool) * (pool @ w_branch_pool)
    return y @ w_out


def setup_inputs(seed: int = 0) -> dict:
    key = jax.random.key(seed)
    ks = jax.random.split(key, 21)

    def nrm(k, shape, s):
        return jax.random.normal(k, shape, jnp.float32) * s

    return {
        "x": nrm(ks[0], (BATCH, SEQ, D_MODEL), 1.0),
        "c": nrm(ks[1], (BATCH, D_MODEL), 1.0),
        "ctx": nrm(ks[2], (BATCH, CTX_LEN, D_MODEL), 1.0),
        "c_ctx": nrm(ks[3], (D_MODEL,), 1.0),
        "w_mod": nrm(ks[4], (DEPTH, D_MODEL, N_MOD * D_MODEL), 0.5 * D_MODEL ** -0.5),
        "b_mod": nrm(ks[5], (DEPTH, N_MOD * D_MODEL), 0.01),
        "g_norm": 1.0 + nrm(ks[6], (DEPTH, 3, D_MODEL), 0.02),
        "w_ffn_gu": nrm(ks[7], (DEPTH, 2, D_MODEL, 2 * D_FF), D_MODEL ** -0.5),
        "w_ffn_down": nrm(ks[8], (DEPTH, 2, D_FF, D_MODEL), D_FF ** -0.5),
        "w_in": nrm(ks[9], (DEPTH, D_MODEL, IN_COLS), D_MODEL ** -0.5),
        "lambda_q1": nrm(ks[10], (DEPTH, HEAD_DIM), 0.1),
        "lambda_k1": nrm(ks[11], (DEPTH, HEAD_DIM), 0.1),
        "lambda_q2": nrm(ks[12], (DEPTH, HEAD_DIM), 0.1),
        "lambda_k2": nrm(ks[13], (DEPTH, HEAD_DIM), 0.1),
        "g_subln": 1.0 + nrm(ks[14], (DEPTH, V_DIM), 0.02),
        "w_pool": nrm(ks[15], (DEPTH, POOL_GROUPS, POOL_GROUP_DIM, POOL_GROUP_DIM), POOL_GROUP_DIM ** -0.5),
        "pool_scale": 1.0 + nrm(ks[16], (DEPTH, POOL_WIDTH), 0.02),
        "w_branch_attn": nrm(ks[17], (DEPTH, ATTN_WIDTH, D_MODEL), ATTN_WIDTH ** -0.5),
        "w_branch_pool": nrm(ks[18], (DEPTH, POOL_WIDTH, D_MODEL), POOL_WIDTH ** -0.5),
        "w_out": nrm(ks[19], (DEPTH, D_MODEL, D_MODEL), D_MODEL ** -0.5),
        "g_final": 1.0 + nrm(ks[20], (D_MODEL,), 0.02),
    }


def reference(x, c, ctx, c_ctx, w_mod, b_mod, g_norm, w_ffn_gu, w_ffn_down, w_in,
              lambda_q1, lambda_k1, lambda_q2, lambda_k2, g_subln, w_pool, pool_scale,
              w_branch_attn, w_branch_pool, w_out, g_final):
    b, l, _ = x.shape
    rows = l // GRID_W
    row_ids = jnp.repeat(jnp.arange(rows), GRID_W)
    col_ids = jnp.tile(jnp.arange(GRID_W), rows)
    n_blocks = l // Q_BLOCK

    lat, cx = x, ctx
    for layer in range(DEPTH):
        last = layer == DEPTH - 1
        mod_lat = (jax.nn.silu(c) @ w_mod[layer] + b_mod[layer])[:, None, :]
        mod_ctx = (jax.nn.silu(c_ctx) @ w_mod[layer] + b_mod[layer])[None, None, :]
        ml = jnp.split(mod_lat, N_MOD, axis=-1)
        mc = jnp.split(mod_ctx, N_MOD, axis=-1)

        lat = lat + 0.5 * ml[2] * swiglu(modulate(rms_norm(lat, g_norm[layer, 0]), ml[0], ml[1]),
                                         w_ffn_gu[layer, 0], w_ffn_down[layer, 0])
        cx = cx + 0.5 * mc[2] * swiglu(modulate(rms_norm(cx, g_norm[layer, 0]), mc[0], mc[1]),
                                       w_ffn_gu[layer, 0], w_ffn_down[layer, 0])

        h_lat = modulate(rms_norm(lat, g_norm[layer, 1]), ml[3], ml[4])
        h_ctx = modulate(rms_norm(cx, g_norm[layer, 1]), mc[3], mc[4])
        proj_lat = h_lat @ w_in[layer]
        q_l = split_qk(proj_lat[..., Q_OFF:K_OFF])
        k_l = split_qk(proj_lat[..., K_OFF:V_OFF])
        v_l = split_v(proj_lat[..., V_OFF:P_OFF])
        u_l = proj_lat[..., P_OFF:G_OFF]
        gates_l = proj_lat[..., G_OFF:]
        if last:
            proj_ctx = h_ctx @ w_in[layer][:, K_OFF:P_OFF]
            k_c = split_qk(proj_ctx[..., :QK_WIDTH])
            v_c = split_v(proj_ctx[..., QK_WIDTH:])
        else:
            proj_ctx = h_ctx @ w_in[layer]
            q_c = split_qk(proj_ctx[..., Q_OFF:K_OFF])
            k_c = split_qk(proj_ctx[..., K_OFF:V_OFF])
            v_c = split_v(proj_ctx[..., V_OFF:P_OFF])
            u_c = proj_ctx[..., P_OFF:G_OFF]
            gates_c = proj_ctx[..., G_OFF:]

        q_l = rope_2d(q_l, row_ids, col_ids)
        k_l = rope_2d(k_l, row_ids, col_ids)
        k_all = jnp.concatenate([k_c, k_l], axis=1)
        v_all = jnp.concatenate([v_c, v_l], axis=1)

        lam_init = 0.8 - 0.6 * math.exp(-0.3 * layer)
        lam = (jnp.exp(jnp.sum(lambda_q1[layer].astype(jnp.float32) * lambda_k1[layer].astype(jnp.float32)))
               - jnp.exp(jnp.sum(lambda_q2[layer].astype(jnp.float32) * lambda_k2[layer].astype(jnp.float32)))
               + lam_init)

        q_blocks = jnp.moveaxis(q_l.reshape(b, n_blocks, Q_BLOCK, N_HEADS, 2, HEAD_DIM), 1, 0)
        o_blocks = lax.map(lambda qb: diff_attn_block(qb, k_all, v_all, lam), q_blocks)
        o_lat = jnp.moveaxis(o_blocks, 0, 1).reshape(b, l, N_HEADS, V_DIM)
        attn_lat = diff_attn_post(o_lat, g_subln[layer], lam_init)
        pool_lat = pool_mix(u_l, w_pool[layer], pool_scale[layer])
        lat = lat + ml[5] * branch_merge(attn_lat, pool_lat, gates_l, w_branch_attn[layer],
                                         w_branch_pool[layer], w_out[layer])

        if not last:
            attn_ctx = diff_attn_post(diff_attn_block(q_c, k_c, v_c, lam), g_subln[layer], lam_init)
            pool_ctx = pool_mix(u_c, w_pool[layer], pool_scale[layer])
            cx = cx + mc[5] * branch_merge(attn_ctx, pool_ctx, gates_c, w_branch_attn[layer],
                                           w_branch_pool[layer], w_out[layer])
            cx = cx + 0.5 * mc[8] * swiglu(modulate(rms_norm(cx, g_norm[layer, 2]), mc[6], mc[7]),
                                           w_ffn_gu[layer, 1], w_ffn_down[layer, 1])

        lat = lat + 0.5 * ml[8] * swiglu(modulate(rms_norm(lat, g_norm[layer, 2]), ml[6], ml[7]),
                                         w_ffn_gu[layer, 1], w_ffn_down[layer, 1])

    return rms_norm(lat, g_final)
```

```cpp
#include <hip/hip_runtime.h>
#include <hip/hip_cooperative_groups.h>
#include <cstdio>
#include <cstdint>
namespace cg = cooperative_groups;

#ifndef WGM_W
#define WGM_W 4
#endif
#ifndef WGM_N
#define WGM_N 2
#endif
#ifndef MK_MULTI
#define MK_MULTI 0
#endif

constexpr size_t MiB = 1u << 20;
constexpr size_t WS_MOD = 0, WS_COS = 640 * 1024, WS_SIN = 644 * 1024, WS_LAM = 648 * 1024, WS_BAR = 704 * 1024, BAR_BYTES = 16 * 1024;
constexpr size_t WS_RSS2 = 23 * MiB, WS_RSS3 = 23 * MiB + 144 * 1024, WS_BIAS2 = 23 * MiB + 272 * 1024, WS_BIAS3 = 23 * MiB + 656 * 1024;
constexpr size_t WS_WGU2 = 1 * MiB, WS_WD2 = 12 * MiB, WS_WM = 18 * MiB, WS_WOUT = 21 * MiB;
constexpr size_t WS_WGU1 = 24 * MiB, WS_WD1 = 35 * MiB, WS_WIN = 41 * MiB, WS_ABUF = 52 * MiB;
constexpr size_t WS_AMERGE = 24 * MiB;
constexpr size_t WS_LAT1 = 124 * MiB, WS_R = 268 * MiB;
constexpr size_t WS_Q = WS_R, WS_K = WS_R + 64 * MiB, WS_V = WS_R + 136 * MiB, WS_U = WS_R + 208 * MiB, WS_H = WS_R, WS_Y = WS_R;
constexpr size_t WS_END = 508 * MiB;

namespace pg8 {
#define PG8_LAS __attribute__((address_space(3)))
typedef unsigned short bf16_t;
typedef short bf16x8 __attribute__((ext_vector_type(8)));
typedef float f32x4 __attribute__((ext_vector_type(4)));
typedef unsigned u32x4 __attribute__((ext_vector_type(4)));
typedef unsigned u32x2 __attribute__((ext_vector_type(2)));
constexpr int BM = 256, BK = 64, HALF = 128, HTB = HALF * BK * 2, STAGE_BYTES = 8 * HTB, NXCD = 8, WGM = 8;

__host__ __device__ __forceinline__ int lds_byte(int r, int c) { const int st = (r >> 4) * 2 + (c >> 5), rr = r & 15, cc = c & 31, ob = rr * 64 + cc * 2; return st * 1024 + (ob ^ (((ob >> 9) & 1) << 5)); }
__host__ __device__ __forceinline__ void stage_rc(int b, int& R, int& C) { const int st = b / 1024, sb = b % 1024, swz = sb ^ (((sb >> 9) & 1) << 5); R = (st >> 1) * 16 + swz / 64; C = (st & 1) * 32 + (swz % 64) / 2; }
__host__ __device__ __forceinline__ int perm32(int rho) { const int n = rho >> 4, i = rho & 15; return 8 * (i >> 2) + 4 * n + (i & 3); }

struct Unit { int pm, pn; };
struct Gemm { const bf16_t* A; const bf16_t* Bt; int M, N, K, lda, ldb; };

struct StaticOrder {
    int nM, nN, nwg, G, c, wgm;
    __host__ __device__ void init(int M, int N, int G_, int c_, int wgm_ = 4) { nM = M / BM; nN = N / BM; nwg = nM * nN; G = G_; c = c_; wgm = wgm_; }
    __host__ __device__ bool next(int i, Unit& u) const {
        const long L = (long)i * G + c; if (L >= nwg) return false;
        int wgid = (int)L; { const int q = nwg / NXCD, r = nwg % NXCD, xcd = wgid % NXCD, off = wgid / NXCD; wgid = (xcd < r ? xcd * (q + 1) : r * (q + 1) + (xcd - r) * q) + off; }
        const int nig = wgm * nN, gid = wgid / nig, fm = gid * wgm, gsz = (nM - fm) < wgm ? (nM - fm) : wgm;
        u.pm = fm + ((wgid % nig) % gsz); u.pn = (wgid % nig) / gsz; return true;
    }
    __device__ __forceinline__ void a_ready(const Unit&) const {}
    __device__ __forceinline__ void done(const Unit&) const {}
};

__device__ __forceinline__ unsigned cvt_pk_bf16(float lo, float hi) { unsigned r; asm volatile("v_cvt_pk_bf16_f32 %0, %1, %2" : "=v"(r) : "v"(lo), "v"(hi)); return r; }
__device__ __forceinline__ float bf_lo(unsigned w) { return __uint_as_float(w << 16); }
__device__ __forceinline__ float bf_hi(unsigned w) { return __uint_as_float(w & 0xffff0000u); }
__device__ __forceinline__ float fast_sigmoid(float v) { return __builtin_amdgcn_rcpf(1.0f + __builtin_amdgcn_exp2f(-1.4426950408889634f * v)); }


template <bool FOLD> struct EpiSwiglu {
    static constexpr bool PERM = true, AFTER_DRAIN = false, HAS_MID = false; static constexpr int MID_T = -1;
    unsigned char* ws;
    __device__ __forceinline__ void operator()(const f32x4 (&acc)[2][2][4][2], const Unit& u, int wr, int wc, int fr, int fq) const {
        const int row0 = u.pm * BM + wr * 64 + fr, col0 = u.pn * HALF + wc * 32 + 8 * fq;
        bf16_t* O = (bf16_t*)(ws + WS_H); constexpr int ldc = 2816; const float* rowss = (const float*)(ws + WS_RSS3); const float* bias = (const float*)(ws + WS_BIAS3);
        f32x4 bv[2][2];
        if (FOLD) { const float* bp = bias + (size_t)(u.pm >> 3) * 5632 + u.pn * BM + wc * 32 + 8 * fq;
#pragma unroll
            for (int bj = 0; bj < 2; ++bj)
#pragma unroll
                for (int n = 0; n < 2; ++n) bv[bj][n] = *(const f32x4*)(bp + bj * HALF + 4 * n); }
#pragma unroll
        for (int ai = 0; ai < 2; ++ai)
#pragma unroll
            for (int m = 0; m < 4; ++m) { const int r = row0 + ai * HALF + m * 16; bf16_t* rowp = O + (size_t)r * ldc + col0;
                float rstd = 1.f; if (FOLD) rstd = __builtin_amdgcn_rsqf(rowss[r] * (1.f / 1024.f) + 1e-6f);
                f32x4 h[2];
#pragma unroll
                for (int n = 0; n < 2; ++n) { f32x4 a = acc[ai][0][m][n], b = acc[ai][1][m][n];
                    if (FOLD) { a = a * rstd + bv[0][n]; b = b * rstd + bv[1][n]; }
#pragma unroll
                    for (int j = 0; j < 4; ++j) h[n][j] = a[j] * fast_sigmoid(a[j]) * b[j]; }
                u32x4 w; w.x = cvt_pk_bf16(h[0][0], h[0][1]); w.y = cvt_pk_bf16(h[0][2], h[0][3]); w.z = cvt_pk_bf16(h[1][0], h[1][1]); w.w = cvt_pk_bf16(h[1][2], h[1][3]);
                *(u32x4*)rowp = w; }
    }
};

template <bool NEXT, int gidx, int sidx, int HALFS> struct EpiResid {
    static constexpr bool PERM = false, AFTER_DRAIN = false, HAS_MID = false; static constexpr int MID_T = -1;
    const float* base_lat; const float* base_ctx; float* out; unsigned char* ws; const float* gn;
    __device__ __forceinline__ void operator()(const f32x4 (&acc)[2][2][4][2], const Unit& u, int wr, int wc, int fr, int fq) const {
        const int col0 = u.pn * BM + wc * 32 + 4 * fq;
        const float* mod = (const float*)(ws + WS_MOD); bf16_t* An = (bf16_t*)(ws + WS_ABUF); float* rowss = (float*)(ws + (sidx == 4 ? WS_RSS2 : WS_RSS3)); constexpr float s = HALFS ? 0.5f : 1.0f;
        const bool isctx = u.pm >= 128; const int brow = isctx ? 16 : (u.pm >> 3);
        const float* mrow = mod + (size_t)brow * 9216 + col0;
        const float* base = isctx ? base_ctx + (size_t)(u.pm - 128) * BM * 1024 : base_lat + (size_t)u.pm * BM * 1024;
        float* outp = out + (size_t)u.pm * BM * 1024;
        f32x4 gv[2][2], wv[2][2];
#pragma unroll
        for (int bj = 0; bj < 2; ++bj)
#pragma unroll
            for (int n = 0; n < 2; ++n) { gv[bj][n] = *(const f32x4*)(mrow + gidx * 1024 + bj * HALF + n * 16) * s;
                if (NEXT) wv[bj][n] = *(const f32x4*)(gn + col0 + bj * HALF + n * 16) * (*(const f32x4*)(mrow + sidx * 1024 + bj * HALF + n * 16) + 1.0f); }
#pragma unroll
        for (int ai = 0; ai < 2; ++ai)
#pragma unroll
            for (int m = 0; m < 4; ++m) { const int rl = ai * HALF + wr * 64 + m * 16 + fr; const size_t off = (size_t)rl * 1024 + col0; float ss = 0.f;
#pragma unroll
                for (int bj = 0; bj < 2; ++bj)
#pragma unroll
                    for (int n = 0; n < 2; ++n) { const f32x4 bs = *(const f32x4*)(base + off + bj * HALF + n * 16); const f32x4 o = bs + gv[bj][n] * acc[ai][bj][m][n];
                        *(f32x4*)(outp + off + bj * HALF + n * 16) = o;
                        if (NEXT) { ss += (o[0] * o[0] + o[1] * o[1]) + (o[2] * o[2] + o[3] * o[3]); const f32x4 a = o * wv[bj][n];
                            u32x2 w; w.x = cvt_pk_bf16(a[0], a[1]); w.y = cvt_pk_bf16(a[2], a[3]); *(u32x2*)(An + (size_t)u.pm * BM * 1024 + off + bj * HALF + n * 16) = w; } }
                if (NEXT) { ss += __shfl_xor(ss, 16); ss += __shfl_xor(ss, 32);
                    if (fq == 0) (void)__hip_atomic_fetch_add(rowss + u.pm * BM + rl, ss, __ATOMIC_RELAXED, __HIP_MEMORY_SCOPE_AGENT); }
                if (m == 3) asm volatile("" ::: "memory"); }
    }
};

struct EpiProj {
    static constexpr bool PERM = true, AFTER_DRAIN = false, HAS_MID = false; static constexpr int MID_T = -1;
    unsigned char* ws; bf16_t* G; int is_ctx;
    __device__ __forceinline__ void operator()(const f32x4 (&acc)[2][2][4][2], const Unit& u, int wr, int wc, int fr, int fq) const {
        bf16_t* Q = (bf16_t*)(ws + WS_Q); bf16_t* K = (bf16_t*)(ws + WS_K); bf16_t* V = (bf16_t*)(ws + WS_V); bf16_t* U = (bf16_t*)(ws + WS_U);
        const float* cosT = (const float*)(ws + WS_COS); const float* sinT = (const float*)(ws + WS_SIN); const float* rowss = (const float*)(ws + WS_RSS2); const float* bias = (const float*)(ws + WS_BIAS2);
        int type, colt;
        if (is_ctx) { type = u.pn < 4 ? 1 : 2; colt = (u.pn & 3) * BM; }
        else { if (u.pn < 4) { type = 0; colt = u.pn * BM; } else if (u.pn < 8) { type = 1; colt = (u.pn - 4) * BM; } else if (u.pn < 12) { type = 2; colt = (u.pn - 8) * BM; }
               else if (u.pn < 14) { type = 3; colt = (u.pn - 12) * BM; } else { type = 4; colt = (u.pn - 14) * BM; } }
        const bool rope = (!is_ctx) && type < 2;
        const int cbase = colt + wc * 32 + 8 * fq;
        f32x4 bv[2][2];
        { const float* bp = bias + (size_t)(is_ctx ? 16 : (u.pm >> 3)) * 5632 + (is_ctx ? 1024 : 0) + u.pn * BM + wc * 32 + 8 * fq;
#pragma unroll
          for (int bj = 0; bj < 2; ++bj)
#pragma unroll
              for (int n = 0; n < 2; ++n) bv[bj][n] = *(const f32x4*)(bp + bj * HALF + n * 4); }
#pragma unroll
        for (int ai = 0; ai < 2; ++ai)
#pragma unroll
            for (int m = 0; m < 4; ++m) {
                const int r = u.pm * BM + ai * HALF + wr * 64 + m * 16 + fr;
                const int kvrow = is_ctx ? ((r >> 8) * 2304 + (r & 255)) : ((r >> 11) * 2304 + 256 + (r & 2047));
                const float rstd = __builtin_amdgcn_rsqf(rowss[(is_ctx ? 32768 : 0) + r] * (1.f / 1024.f) + 1e-6f);
                bf16_t* dst;
                if (type == 0) dst = Q + (size_t)r * 1024; else if (type == 1) dst = K + (size_t)kvrow * 1024; else if (type == 2) dst = V + (size_t)kvrow * 1024;
                else if (type == 3) dst = U + (size_t)r * 512; else dst = G + (size_t)r * 2048;
                dst += cbase;
                f32x4 cs = {1.f, 1.f, 1.f, 1.f}, sn = {0.f, 0.f, 0.f, 0.f};
                if (rope) { const int pos = (wc & 1) ? (r & 63) : ((r >> 6) & 31); cs = *(const f32x4*)(cosT + pos * 16 + 4 * fq); sn = *(const f32x4*)(sinT + pos * 16 + 4 * fq); }
#pragma unroll
                for (int bj = 0; bj < 2; ++bj) { f32x4 v0 = acc[ai][bj][m][0] * rstd + bv[bj][0], v1 = acc[ai][bj][m][1] * rstd + bv[bj][1];
                    if (rope) { const f32x4 o0 = v0 * cs - v1 * sn, o1 = v1 * cs + v0 * sn; v0 = o0; v1 = o1; }
                    if (type == 4) {
#pragma unroll
                        for (int j = 0; j < 4; ++j) { v0[j] = fast_sigmoid(v0[j]); v1[j] = fast_sigmoid(v1[j]); } }
                    u32x4 w; w.x = cvt_pk_bf16(v0[0], v0[1]); w.y = cvt_pk_bf16(v0[2], v0[3]); w.z = cvt_pk_bf16(v1[0], v1[1]); w.w = cvt_pk_bf16(v1[2], v1[3]);
                    *(u32x4*)(dst + bj * HALF) = w; }
            }
    }
};

template <bool SECOND> struct EpiMerge {
    static constexpr bool PERM = true, AFTER_DRAIN = false, HAS_MID = false; static constexpr int MID_T = -1;
    const bf16_t* G; bf16_t* Y;
    __device__ __forceinline__ void operator()(const f32x4 (&acc)[2][2][4][2], const Unit& u, int wr, int wc, int fr, int fq) const {
        const int row0 = u.pm * BM + wr * 64 + fr, col0 = u.pn * BM + wc * 32 + 8 * fq;
#pragma unroll
        for (int ai = 0; ai < 2; ++ai)
#pragma unroll
            for (int m = 0; m < 4; ++m) { const size_t rr = (size_t)(row0 + ai * HALF + m * 16);
#pragma unroll
                for (int bj = 0; bj < 2; ++bj) { const u32x4 p = *(const u32x4*)(G + rr * 2048 + (SECOND ? 1024 : 0) + col0 + bj * HALF);
                    f32x4 v0 = acc[ai][bj][m][0], v1 = acc[ai][bj][m][1];
                    v0[0] *= bf_lo(p.x); v0[1] *= bf_hi(p.x); v0[2] *= bf_lo(p.y); v0[3] *= bf_hi(p.y); v1[0] *= bf_lo(p.z); v1[1] *= bf_hi(p.z); v1[2] *= bf_lo(p.w); v1[3] *= bf_hi(p.w);
                    bf16_t* yp = Y + rr * 1024 + col0 + bj * HALF;
                    if (SECOND) { const u32x4 y = *(const u32x4*)yp;
                        v0[0] += bf_lo(y.x); v0[1] += bf_hi(y.x); v0[2] += bf_lo(y.y); v0[3] += bf_hi(y.y); v1[0] += bf_lo(y.z); v1[1] += bf_hi(y.z); v1[2] += bf_lo(y.w); v1[3] += bf_hi(y.w); }
                    u32x4 w; w.x = cvt_pk_bf16(v0[0], v0[1]); w.y = cvt_pk_bf16(v0[2], v0[3]); w.z = cvt_pk_bf16(v1[0], v1[1]); w.w = cvt_pk_bf16(v1[2], v1[3]);
                    *(u32x4*)yp = w; }
                asm volatile("" ::: "memory"); }
    }
};

template <class Epi, class Sched, bool ALIGN_EPI = false, bool SP2 = false>
__device__ __forceinline__ void gemm_phase(PG8_LAS unsigned char* lds, const Gemm g, const Sched& S, const Epi& E) {
    const int tid = threadIdx.x, wid = __builtin_amdgcn_readfirstlane(tid >> 6), lane = tid & 63, wr = wid >> 2, wc = wid & 3, fr = lane & 15, fq = lane >> 4;
    const int K = g.K, nt = K / BK;
    unsigned voffA[2], voffB[2];
#pragma unroll
    for (int i = 0; i < 2; ++i) { int R, C; stage_rc(tid * 16 + i * 8192, R, C); const int Rb = Epi::PERM ? ((R & ~31) + perm32(R & 31)) : R;
        voffA[i] = (unsigned)(R * g.lda + C) * 2u; voffB[i] = (unsigned)(Rb * g.ldb + C) * 2u; }
    const size_t kstep = (size_t)(BK * 2);
    const size_t hstepA = (size_t)HALF * g.lda * 2, hstepB = (size_t)HALF * g.ldb * 2;
    const size_t tstepA = 2 * hstepA, tstepB = 2 * hstepB;
    const unsigned ldsw = (unsigned)wid * 1024u;
    const int aoff = lds_byte(wr * 64 + fr, fq * 8), boff = lds_byte(wc * 32 + fr, fq * 8);
#define PG8_SA(b, h) (((b) * 2 + (h)) * HTB)
#define PG8_SB(b, h) ((4 + (b) * 2 + (h)) * HTB)
#define PG8_STAGE(bufoff, gbase, voff) do { _Pragma("unroll") for (int _i = 0; _i < 2; ++_i) \
        __builtin_amdgcn_global_load_lds((const unsigned*)((const char*)(gbase) + (voff)[_i]), (PG8_LAS unsigned*)(lds + (bufoff) + ldsw + _i * 8192), 16, 0, 0); } while (0)
#define PG8_LDA(dst, b, h) do { _Pragma("unroll") for (int m = 0; m < 4; ++m) _Pragma("unroll") for (int k = 0; k < 2; ++k) dst[m][k] = *(const PG8_LAS bf16x8*)(lds + PG8_SA(b, h) + aoff + m * 2048 + k * 1024); } while (0)
#define PG8_LDB(dst, b, h) do { _Pragma("unroll") for (int n = 0; n < 2; ++n) _Pragma("unroll") for (int k = 0; k < 2; ++k) dst[n][k] = *(const PG8_LAS bf16x8*)(lds + PG8_SB(b, h) + boff + n * 2048 + k * 1024); } while (0)
#define PG8_MMA(ai, bj, At, Bt) do { __builtin_amdgcn_s_setprio(1); _Pragma("unroll") for (int m = 0; m < 4; ++m) _Pragma("unroll") for (int n = 0; n < 2; ++n) _Pragma("unroll") for (int k = 0; k < 2; ++k) \
        acc[ai][bj][m][n] = __builtin_amdgcn_mfma_f32_16x16x32_bf16(Bt[n][k], At[m][k], acc[ai][bj][m][n], 0, 0, 0); __builtin_amdgcn_s_setprio(0); } while (0)
#define PG8_WAIT_V(n) asm volatile("s_waitcnt vmcnt(" #n ")" ::: "memory")
#define PG8_WAIT_L(n) asm volatile("s_waitcnt lgkmcnt(" #n ")" ::: "memory")
#define PG8_BAR __builtin_amdgcn_s_barrier()
#define PG8_SCHED __builtin_amdgcn_sched_barrier(0)
    Unit cur, nxt; int ui = 0;
    if (!S.next(0, cur)) return;
    f32x4 acc[2][2][4][2];
#pragma unroll
    for (int a = 0; a < 2; ++a)
#pragma unroll
        for (int b = 0; b < 2; ++b)
#pragma unroll
            for (int m = 0; m < 4; ++m)
#pragma unroll
                for (int n = 0; n < 2; ++n) acc[a][b][m][n] = (f32x4){0.f, 0.f, 0.f, 0.f};
    bf16x8 At[4][2], B0[2][2], B1[2][2];
    const char* cA = (const char*)g.A + (size_t)cur.pm * tstepA; const char* cB = (const char*)g.Bt + (size_t)cur.pn * tstepB;
    S.a_ready(cur);
    if constexpr (SP2) {
        PG8_STAGE(PG8_SB(0, 0), cB, voffB); PG8_STAGE(PG8_SB(0, 1), cB + hstepB, voffB); PG8_STAGE(PG8_SA(0, 0), cA, voffA); PG8_STAGE(PG8_SA(0, 1), cA + hstepA, voffA);
        if (wr == 1) PG8_BAR;
        PG8_WAIT_V(2); PG8_BAR;
        PG8_STAGE(PG8_SB(1, 0), cB + kstep, voffB); PG8_STAGE(PG8_SA(1, 0), cA + kstep, voffA); PG8_STAGE(PG8_SB(1, 1), cB + hstepB + kstep, voffB);
        PG8_WAIT_V(6); PG8_BAR;
    } else {
        PG8_STAGE(PG8_SB(0, 0), cB, voffB); PG8_STAGE(PG8_SA(0, 0), cA, voffA); PG8_STAGE(PG8_SB(0, 1), cB + hstepB, voffB); PG8_STAGE(PG8_SA(0, 1), cA + hstepA, voffA);
        if (wr == 1) PG8_BAR;
        PG8_WAIT_V(4); PG8_BAR;
        PG8_STAGE(PG8_SB(1, 0), cB + kstep, voffB); PG8_STAGE(PG8_SA(1, 0), cA + kstep, voffA); PG8_STAGE(PG8_SB(1, 1), cB + hstepB + kstep, voffB);
        PG8_WAIT_V(6); PG8_BAR;
    }
    for (;;) {
        const bool has_next = S.next(ui + 1, nxt);
        const char* nA = has_next ? (const char*)g.A + (size_t)nxt.pm * tstepA : cA; const char* nB = has_next ? (const char*)g.Bt + (size_t)nxt.pn * tstepB : cB;
        for (int t = 0; t < nt; t += 2) {
            const bool last = (t == nt - 2);
            const char* a1 = cA + (size_t)(t + 1) * kstep;
            const char* a2 = last ? nA : cA + (size_t)(t + 2) * kstep; const char* b2 = last ? nB : cB + (size_t)(t + 2) * kstep;
            const char* a3 = a2 + kstep; const char* b3 = b2 + kstep;
            if (last && has_next) S.a_ready(nxt);
            if constexpr (SP2) {
            PG8_LDB(B0, 0, 0); PG8_LDB(B1, 0, 1); PG8_SCHED; PG8_LDA(At, 0, 0); PG8_STAGE(PG8_SA(1, 1), a1 + hstepA, voffA);
            PG8_WAIT_V(8); PG8_WAIT_L(0); PG8_BAR; PG8_MMA(0, 0, At, B0); PG8_MMA(0, 1, At, B1); PG8_BAR; PG8_SCHED;
            PG8_LDA(At, 0, 1); PG8_STAGE(PG8_SB(0, 0), b2, voffB); PG8_STAGE(PG8_SB(0, 1), b2 + hstepB, voffB); PG8_STAGE(PG8_SA(0, 0), a2, voffA);
            PG8_WAIT_V(8); PG8_WAIT_L(0); PG8_BAR; PG8_MMA(1, 0, At, B0); PG8_MMA(1, 1, At, B1); PG8_BAR; PG8_SCHED;
            PG8_LDB(B0, 1, 0); PG8_LDB(B1, 1, 1); PG8_SCHED; PG8_LDA(At, 1, 0); PG8_STAGE(PG8_SA(0, 1), a2 + hstepA, voffA);
            PG8_WAIT_V(8); PG8_WAIT_L(0); PG8_BAR; PG8_MMA(0, 0, At, B0); PG8_MMA(0, 1, At, B1); PG8_BAR; PG8_SCHED;
            PG8_LDA(At, 1, 1); PG8_STAGE(PG8_SB(1, 0), b3, voffB); PG8_STAGE(PG8_SB(1, 1), b3 + hstepB, voffB); PG8_STAGE(PG8_SA(1, 0), a3, voffA);
            PG8_WAIT_V(8); PG8_WAIT_L(0); PG8_BAR; PG8_MMA(1, 0, At, B0); PG8_MMA(1, 1, At, B1); PG8_BAR; PG8_SCHED;
            } else {
            PG8_LDB(B0, 0, 0); PG8_SCHED; PG8_LDA(At, 0, 0); PG8_STAGE(PG8_SA(1, 1), a1 + hstepA, voffA);
            PG8_WAIT_L(8); PG8_BAR; PG8_WAIT_L(0); PG8_MMA(0, 0, At, B0); PG8_BAR; PG8_SCHED;
            PG8_LDB(B1, 0, 1); PG8_STAGE(PG8_SB(0, 0), b2, voffB);
            PG8_BAR; PG8_WAIT_L(0); PG8_MMA(0, 1, At, B1); PG8_BAR;
            PG8_LDA(At, 0, 1); PG8_STAGE(PG8_SA(0, 0), a2, voffA);
            PG8_BAR; PG8_WAIT_L(0); PG8_MMA(1, 0, At, B0); PG8_BAR; PG8_SCHED;
            PG8_STAGE(PG8_SB(0, 1), b2 + hstepB, voffB);
            PG8_WAIT_V(6); PG8_BAR; PG8_MMA(1, 1, At, B1); PG8_BAR;
            PG8_LDB(B0, 1, 0); PG8_SCHED; PG8_LDA(At, 1, 0); PG8_STAGE(PG8_SA(0, 1), a2 + hstepA, voffA);
            PG8_WAIT_L(8); PG8_BAR; PG8_WAIT_L(0); PG8_MMA(0, 0, At, B0); PG8_BAR; PG8_SCHED;
            PG8_LDB(B1, 1, 1); PG8_STAGE(PG8_SB(1, 0), b3, voffB);
            PG8_BAR; PG8_WAIT_L(0); PG8_MMA(0, 1, At, B1); PG8_BAR;
            PG8_LDA(At, 1, 1); PG8_STAGE(PG8_SA(1, 0), a3, voffA);
            PG8_BAR; PG8_WAIT_L(0); PG8_MMA(1, 0, At, B0); PG8_BAR; PG8_SCHED;
            PG8_STAGE(PG8_SB(1, 1), b3 + hstepB, voffB);
            PG8_WAIT_V(6); PG8_BAR; PG8_MMA(1, 1, At, B1); PG8_BAR;
            }
        }
        if constexpr (ALIGN_EPI) { if (wr == 0) PG8_BAR; }
        if constexpr (!Epi::AFTER_DRAIN) { E(acc, cur, wr, wc, fr, fq); S.done(cur); }
        if (!has_next) break;
#pragma unroll
        for (int a = 0; a < 2; ++a)
#pragma unroll
            for (int b = 0; b < 2; ++b)
#pragma unroll
                for (int m = 0; m < 4; ++m)
#pragma unroll
                    for (int n = 0; n < 2; ++n) acc[a][b][m][n] = (f32x4){0.f, 0.f, 0.f, 0.f};
        cur = nxt; cA = nA; cB = nB; ++ui;
        if constexpr (ALIGN_EPI) { if (wr == 1) PG8_BAR; }
    }
    PG8_WAIT_V(0);
    if constexpr (!ALIGN_EPI) { if (wr == 0) PG8_BAR; }
    PG8_BAR;
#undef PG8_SA
#undef PG8_SB
#undef PG8_STAGE
#undef PG8_LDA
#undef PG8_LDB
#undef PG8_MMA
#undef PG8_WAIT_V
#undef PG8_WAIT_L
#undef PG8_BAR
#undef PG8_SCHED
}
}

namespace att {
typedef unsigned short bf16;
using bf16x8 = __attribute__((ext_vector_type(8))) short;
using s16x4  = __attribute__((ext_vector_type(4))) short;
using f32x16 = __attribute__((ext_vector_type(16))) float;
using f32x4  = __attribute__((ext_vector_type(4))) float;
using u32x4  = __attribute__((ext_vector_type(4))) unsigned;
constexpr int NW = 8, QBLK = 32, KVBLK = 64, LDX = 1024, SKV = 2304, SQ = 2048, LDO = 1536;
constexpr float SCALE = 0.125f, THR = 8.f;
constexpr int SHM_V = KVBLK * 128 * 2, SHM_K = KVBLK * 128 * 2;
constexpr int OST = 132;
constexpr int LDS_WS_OFF = 2 * 128 * OST * 4;
constexpr int LDS_BYTES = LDS_WS_OFF + NW * 64 * 4;
#define KSWZ(row, colB) ((row) * 256 + ((colB) ^ (((row) & 7) << 4)))
#define SBAR() __builtin_amdgcn_sched_barrier(0)
__device__ __forceinline__ int crow(int r, int hi) { return (r & 3) + 8 * (r >> 2) + 4 * hi; }
__device__ __forceinline__ unsigned cvtpk(float lo, float hi) { unsigned r; asm volatile("v_cvt_pk_bf16_f32 %0, %1, %2" : "=v"(r) : "v"(lo), "v"(hi)); return r; }
__device__ __forceinline__ bf16x8 ld8(const bf16* p) { return *reinterpret_cast<const bf16x8*>(p); }

__device__ __forceinline__ void partialSM(f32x16& p0, f32x16& p1, float& m_reg, float& mn, float& alpha, bool& resc) {
  constexpr float C = SCALE * 1.4426950408889634f;
  float pmax = p0[0];
#pragma unroll
  for (int r = 1; r < 16; ++r) pmax = fmaxf(pmax, p0[r]);
#pragma unroll
  for (int r = 0; r < 16; ++r) pmax = fmaxf(pmax, p1[r]);
  { auto rr = __builtin_amdgcn_permlane32_swap(__float_as_uint(pmax), __float_as_uint(pmax), false, false);
    pmax = fmaxf(__uint_as_float(rr[0]), __uint_as_float(rr[1])); }
  if (__builtin_expect(__all(pmax - m_reg <= THR / SCALE), 1)) { mn = m_reg; alpha = 1.f; resc = false; }
  else { mn = fmaxf(m_reg, pmax); alpha = __builtin_amdgcn_exp2f((m_reg - mn) * C); m_reg = mn; resc = true; }
  float mnC = -mn * C;
#pragma unroll
  for (int r = 0; r < 16; ++r) p0[r] = fmaf(p0[r], C, mnC);
#pragma unroll
  for (int r = 0; r < 16; ++r) p1[r] = fmaf(p1[r], C, mnC);
#pragma unroll
  for (int r = 0; r < 16; ++r) p0[r] = __builtin_amdgcn_exp2f(p0[r]);
}
__device__ __forceinline__ void finishSM(f32x16& p0, f32x16& p1, float alpha, float& l_reg, bf16x8& pa0, bf16x8& pa1, bf16x8& pa2, bf16x8& pa3) {
#pragma unroll
  for (int r = 0; r < 16; ++r) p1[r] = __builtin_amdgcn_exp2f(p1[r]);
  float ps = 0;
#pragma unroll
  for (int r = 0; r < 16; ++r) ps += p0[r];
#pragma unroll
  for (int r = 0; r < 16; ++r) ps += p1[r];
  { auto rr = __builtin_amdgcn_permlane32_swap(__float_as_uint(ps), __float_as_uint(ps), false, false);
    ps = __uint_as_float(rr[0]) + __uint_as_float(rr[1]); }
  l_reg = l_reg * alpha + ps;
#define PK4(P, BASE, OUT) do { unsigned a0 = cvtpk(P[BASE + 0], P[BASE + 1]), a1 = cvtpk(P[BASE + 2], P[BASE + 3]);   \
    unsigned b0 = cvtpk(P[BASE + 4], P[BASE + 5]), b1 = cvtpk(P[BASE + 6], P[BASE + 7]);                              \
    auto r0 = __builtin_amdgcn_permlane32_swap(a0, b0, false, false); auto r1 = __builtin_amdgcn_permlane32_swap(a1, b1, false, false); \
    u32x4 w = {r0[0], r1[0], r0[1], r1[1]}; OUT = *reinterpret_cast<bf16x8*>(&w); } while (0)
  PK4(p0, 0, pa0); PK4(p0, 8, pa1); PK4(p1, 0, pa2); PK4(p1, 8, pa3);
#undef PK4
}
__device__ __forceinline__ void qkt(f32x16& p0, f32x16& p1, const bf16* Ks, const bf16x8* qr, int r32, int hi, int comp) {
  p0 = f32x16{}; p1 = f32x16{};
#pragma unroll
  for (int d0 = 0; d0 < 4; ++d0) { int cb = (comp * 64 + d0 * 16 + hi * 8) * 2;
    bf16x8 b0 = *reinterpret_cast<const bf16x8*>((const char*)Ks + KSWZ(r32, cb));
    bf16x8 b1 = *reinterpret_cast<const bf16x8*>((const char*)Ks + KSWZ(32 + r32, cb));
    p0 = __builtin_amdgcn_mfma_f32_32x32x16_bf16(b0, qr[d0], p0, 0, 0, 0);
    p1 = __builtin_amdgcn_mfma_f32_32x32x16_bf16(b1, qr[d0], p1, 0, 0, 0); }
}
__device__ __forceinline__ int v_st(int k, int c) { const int kk = (k & ~0xC) | ((k & 4) << 1) | ((k & 8) >> 1); return ((kk >> 3) * 4 + (c >> 5)) * 512 + ((kk & 7) * 32 + (c & 31)) * 2; }
__device__ __forceinline__ int v_rd_base(int lane) { return ((lane & 3) << 3) | (((lane >> 2) & 3) << 6) | (((lane >> 4) & 1) << 5) | (((lane >> 5) & 1) << 8); }
constexpr int v_rd_off(int d0, int ks, int half) { return d0 * 512 + ks * 4096 + half * 2048; }
template <int OFF> __device__ __forceinline__ s16x4 tr_read(int vb) {
  s16x4 r; asm volatile("ds_read_b64_tr_b16 %0, %1 offset:%2" : "=&v"(r) : "v"(vb), "i"(OFF) : "memory"); return r;
}
template <int D0> __device__ __forceinline__ void pv_one(f32x16& od, int vb, bf16x8 pa0, bf16x8 pa1, bf16x8 pa2, bf16x8 pa3) {
  const s16x4 l0 = tr_read<v_rd_off(D0, 0, 0)>(vb), h0 = tr_read<v_rd_off(D0, 0, 1)>(vb), l1 = tr_read<v_rd_off(D0, 1, 0)>(vb), h1 = tr_read<v_rd_off(D0, 1, 1)>(vb);
  const s16x4 l2 = tr_read<v_rd_off(D0, 2, 0)>(vb), h2 = tr_read<v_rd_off(D0, 2, 1)>(vb), l3 = tr_read<v_rd_off(D0, 3, 0)>(vb), h3 = tr_read<v_rd_off(D0, 3, 1)>(vb);
  asm volatile("s_waitcnt lgkmcnt(0)" ::: "memory"); SBAR();
#define PK(L, H) (bf16x8){L[0], L[1], L[2], L[3], H[0], H[1], H[2], H[3]}
  od = __builtin_amdgcn_mfma_f32_32x32x16_bf16(pa0, PK(l0, h0), od, 0, 0, 0);
  od = __builtin_amdgcn_mfma_f32_32x32x16_bf16(pa1, PK(l1, h1), od, 0, 0, 0);
  od = __builtin_amdgcn_mfma_f32_32x32x16_bf16(pa2, PK(l2, h2), od, 0, 0, 0);
  od = __builtin_amdgcn_mfma_f32_32x32x16_bf16(pa3, PK(l3, h3), od, 0, 0, 0);
#undef PK
}
__device__ __forceinline__ void pv_d0(f32x16* o, int vb, bf16x8 pa0, bf16x8 pa1, bf16x8 pa2, bf16x8 pa3) {
  pv_one<0>(o[0], vb, pa0, pa1, pa2, pa3); pv_one<1>(o[1], vb, pa0, pa1, pa2, pa3); pv_one<2>(o[2], vb, pa0, pa1, pa2, pa3); pv_one<3>(o[3], vb, pa0, pa1, pa2, pa3);
}

__device__ __forceinline__ void diff_attn_unit(const bf16* __restrict__ Qb, const bf16* __restrict__ Kh, const bf16* __restrict__ Vh, bf16* __restrict__ Ob,
                                               const float* __restrict__ gsub, float lam, float osc, char* lds) {
  const int tid = threadIdx.x, wid = tid >> 6, lane = tid & 63, r32 = lane & 31, hi = lane >> 5;
  const int comp = wid >> 2, grp = wid & 3;
  bf16* V_lds = (bf16*)lds; bf16* K_lds = (bf16*)(lds + 3 * SHM_V);
  float* ws = (float*)(lds + LDS_WS_OFF) + wid * 64; float* li_l = ws; float* al_l = ws + 32;
  float m_reg = -1e30f, l_reg = 0; f32x16 o[4] = {}; bf16x8 qr[4];
  const bf16* Qw = Qb + (long)(grp * QBLK + r32) * LDX + comp * 64 + hi * 8;
#pragma unroll
  for (int d0 = 0; d0 < 4; ++d0) qr[d0] = ld8(Qw + d0 * 16);
  typedef __attribute__((address_space(3))) unsigned lds_u32;
  __attribute__((address_space(3))) char* lds3 = (__attribute__((address_space(3))) char*)lds;
  const int vb0 = (int)(uintptr_t)V_lds + v_rd_base(lane);
  int koff[2], voff[2];
#pragma unroll
  for (int i = 0; i < 2; ++i) { const int row = 32 * i + 4 * wid + (lane >> 4), ch = (lane & 15) ^ (row & 7); koff[i] = row * LDX + ch * 8;
    const int st = 2 * (2 * wid + i) + (lane >> 5), kk = (st >> 2) * 8 + ((lane & 31) >> 2), c = (st & 3) * 32 + (lane & 3) * 8, k = (kk & ~0xC) | ((kk & 4) << 1) | ((kk & 8) >> 1);
    voff[i] = k * LDX + c; }
  const int kdst = 3 * SHM_V + 4 * wid * 256, vdst = 2 * wid * 1024;
#define DMAK(k0, slot) do { _Pragma("unroll") for (int i_ = 0; i_ < 2; ++i_) __builtin_amdgcn_global_load_lds((const unsigned*)(Kh + (long)(k0) * LDX + koff[i_]), (lds_u32*)(lds3 + kdst + (slot) * SHM_K + i_ * 8192), 16, 0, 0); } while (0)
#define DMAV(k0, soff) do { _Pragma("unroll") for (int i_ = 0; i_ < 2; ++i_) __builtin_amdgcn_global_load_lds((const unsigned*)(Vh + (long)(k0) * LDX + voff[i_]), (lds_u32*)(lds3 + vdst + (soff) + i_ * 1024), 16, 0, 0); } while (0)
#define VMW0() asm volatile("s_waitcnt vmcnt(0)" ::: "memory")
#define RESC(a) do { if (rs_) { if (hi == 0) al_l[r32] = (a); asm volatile("s_waitcnt lgkmcnt(0)" ::: "memory"); \
    _Pragma("unroll") for (int d = 0; d < 4; ++d) _Pragma("unroll") for (int r = 0; r < 16; ++r) o[d][r] *= al_l[crow(r, hi)]; } } while (0)
  bool rs_ = false;
  f32x16 pA0, pA1, pB0, pB1; float mnA, mnB, alA, alB; bf16x8 pa0, pa1, pa2, pa3; constexpr int NT = SKV / KVBLK;
  int vw = SHM_V, va = 0, vbb = 2 * SHM_V;
#define BARSTUFF(j) do { VMW0(); __syncthreads(); \
    if ((j) + 1 < NT) DMAK(((j) + 1) * KVBLK, ((j) + 1) & 1); DMAV((j) * KVBLK, vw); } while (0)
#define ROTV() do { vbb = va; va = vw; vw = (vw == 2 * SHM_V) ? 0 : vw + SHM_V; } while (0)
#define XS(j, C0, C1, P0, P1, ALP) do { qkt(C0, C1, (bf16*)((char*)K_lds + ((j) & 1) * SHM_K), qr, r32, hi, comp); finishSM(P0, P1, ALP, l_reg, pa0, pa1, pa2, pa3); SBAR(); } while (0)
#define YS(C0, C1, MNC, ALC, VOFF) do { pv_d0(o, vb0 + (VOFF), pa0, pa1, pa2, pa3); partialSM(C0, C1, m_reg, MNC, ALC, rs_); RESC(ALC); } while (0)
  DMAK(0, 0); DMAV(0, 0); VMW0(); __syncthreads();
  DMAK(KVBLK, 1);
  if (comp == 0) {
    SBAR(); qkt(pA0, pA1, K_lds, qr, r32, hi, comp); partialSM(pA0, pA1, m_reg, mnA, alA, rs_);
    for (int j = 1; j + 1 < NT; j += 2) {
      BARSTUFF(j);     XS(j, pB0, pB1, pA0, pA1, alA);     YS(pB0, pB1, mnB, alB, va); ROTV();
      BARSTUFF(j + 1); XS(j + 1, pA0, pA1, pB0, pB1, alB); YS(pA0, pA1, mnA, alA, va); ROTV();
    }
    BARSTUFF(NT - 1); XS(NT - 1, pB0, pB1, pA0, pA1, alA); YS(pB0, pB1, mnB, alB, va); ROTV();
    VMW0(); __syncthreads();
    finishSM(pB0, pB1, alB, l_reg, pa0, pa1, pa2, pa3); SBAR();
    pv_d0(o, vb0 + va, pa0, pa1, pa2, pa3);
  } else {
    SBAR(); qkt(pA0, pA1, K_lds, qr, r32, hi, comp);
    BARSTUFF(1); partialSM(pA0, pA1, m_reg, mnA, alA, rs_); XS(1, pB0, pB1, pA0, pA1, alA); ROTV();
    for (int j = 2; j + 1 < NT; j += 2) {
      BARSTUFF(j);     YS(pB0, pB1, mnB, alB, vbb); XS(j, pA0, pA1, pB0, pB1, alB);     ROTV();
      BARSTUFF(j + 1); YS(pA0, pA1, mnA, alA, vbb); XS(j + 1, pB0, pB1, pA0, pA1, alA); ROTV();
    }
    VMW0(); __syncthreads();
    YS(pB0, pB1, mnB, alB, vbb);
    finishSM(pB0, pB1, alB, l_reg, pa0, pa1, pa2, pa3); SBAR();
    pv_d0(o, vb0 + va, pa0, pa1, pa2, pa3);
  }
#undef BARSTUFF
#undef ROTV
#undef XS
#undef YS
  if (hi == 0) li_l[r32] = l_reg; asm volatile("s_waitcnt lgkmcnt(0)" ::: "memory");
  float rli[16];
  const float sgn = comp ? -lam : 1.f;
#pragma unroll
  for (int r = 0; r < 16; ++r) rli[r] = __builtin_amdgcn_rcpf(li_l[crow(r, hi)]) * sgn;
  __syncthreads();
  float* stg = (float*)lds + comp * (128 * OST);
#pragma unroll
  for (int r = 0; r < 16; ++r) { const int orow = grp * QBLK + crow(r, hi);
#pragma unroll
    for (int d0 = 0; d0 < 4; ++d0) stg[orow * OST + d0 * 32 + r32] = o[d0][r] * rli[r]; }
  __syncthreads();
  { const int row = tid >> 2, q4 = tid & 3; const float* s0 = (const float*)lds + row * OST + q4 * 32; const float* s1 = s0 + 128 * OST;
    f32x4 v[8]; float ss = 0.f;
#pragma unroll
    for (int i = 0; i < 8; ++i) { v[i] = *(const f32x4*)(s0 + 4 * i) + *(const f32x4*)(s1 + 4 * i); ss += (v[i][0] * v[i][0] + v[i][1] * v[i][1]) + (v[i][2] * v[i][2] + v[i][3] * v[i][3]); }
    ss += __shfl_xor(ss, 1); ss += __shfl_xor(ss, 2);
    const float rstd = osc * __builtin_amdgcn_rsqf(ss * (1.f / 128.f) + 1e-6f);
    bf16* orow = Ob + (long)row * LDO + q4 * 32;
#pragma unroll
    for (int i = 0; i < 4; ++i) { const f32x4 g0 = *(const f32x4*)(gsub + q4 * 32 + 8 * i), g1 = *(const f32x4*)(gsub + q4 * 32 + 8 * i + 4);
      const f32x4 a = v[2 * i] * g0 * rstd, b = v[2 * i + 1] * g1 * rstd;
      u32x4 w = {cvtpk(a[0], a[1]), cvtpk(a[2], a[3]), cvtpk(b[0], b[1]), cvtpk(b[2], b[3])};
      *(u32x4*)(orow + 8 * i) = w; } }
  __syncthreads();
#undef DMAK
#undef DMAV
#undef VMW0
#undef RESC
}
#undef SBAR
}


#define XB_TMO      128
#define XB_XCNT(j)  (256  + 64 * (j))
#define XB_XSUB(j)  (1280 + 64 * (j))
#define XB_XGEN(j)  (2304 + 64 * (j))
#define XB_TOP      3328
#define XB_TOPGEN   3392
#define XCD_BAR_WORDS 3456
#define XB_SPIN_CAP (1u << 18)
#define XLAS __attribute__((address_space(3)))
__device__ __forceinline__ unsigned xb_ld(unsigned* p)              { return __hip_atomic_load(p, __ATOMIC_RELAXED, __HIP_MEMORY_SCOPE_AGENT); }
__device__ __forceinline__ unsigned xb_add(unsigned* p, unsigned v) { return __hip_atomic_fetch_add(p, v, __ATOMIC_RELAXED, __HIP_MEMORY_SCOPE_AGENT); }
__device__ __forceinline__ unsigned xb_xcc_id() { return (unsigned)__builtin_amdgcn_s_getreg((3 << 11) | 20) & 0xFu; }
#define XB_SPIN(cond, bar) do { unsigned _sp = 0; while (cond) { __builtin_amdgcn_s_sleep(1); \
    if ((++_sp & 255u) == 0u) { if (xb_ld(&(bar)[XB_TMO])) break; if (_sp > XB_SPIN_CAP) { atomicAdd(&(bar)[XB_TMO], 1u); break; } } } } while (0)
struct XcdBarrier { unsigned* bar; unsigned x; volatile XLAS unsigned* st; };
__device__ __forceinline__ XcdBarrier xcd_barrier_post(unsigned* bar, volatile XLAS unsigned* st) {
    XcdBarrier b; b.bar = bar; b.x = xb_xcc_id(); b.st = st;
    if (threadIdx.x == 0) (void)xb_add(&bar[XB_XCNT(b.x)], 1u);
    return b;
}
__device__ __forceinline__ void xcd_barrier_complete(unsigned* bar, unsigned x, unsigned& nloc, unsigned& nx) {
    const unsigned G = gridDim.x * gridDim.y * gridDim.z;
    unsigned sum, cnt, mine, sp = 0u;
    for (;;) {
        sum = 0u; cnt = 0u; mine = 0u;
#pragma unroll
        for (unsigned j = 0; j < 16; ++j) { const unsigned c = xb_ld(&bar[XB_XCNT(j)]); sum += c; cnt += (c > 0u) ? 1u : 0u; mine = (j == x) ? c : mine; }
        if (sum == G) break;
        __builtin_amdgcn_s_sleep(1);
        if ((++sp & 255u) == 0u) { if (xb_ld(&bar[XB_TMO])) break; if (sp > XB_SPIN_CAP) { atomicAdd(&bar[XB_TMO], 1u); break; } }
    }
    nloc = mine > 0u ? mine : 1u; nx = cnt > 0u ? cnt : 1u;
}
__device__ __forceinline__ void xcd_barrier(const XcdBarrier& b) {
    asm volatile("s_waitcnt vmcnt(0)" ::: "memory");
    __syncthreads();
    if (threadIdx.x == 0) {
        unsigned* bar = b.bar;
        __builtin_amdgcn_s_waitcnt(0);
        unsigned nloc = b.st[0], nx = b.st[1];
        if (nloc == 0u) { xcd_barrier_complete(bar, b.x, nloc, nx); b.st[0] = nloc; b.st[1] = nx; }
        const unsigned old = xb_add(&bar[XB_XSUB(b.x)], 1u);
        const unsigned gen = old / nloc;
        if (old + 1u == (gen + 1u) * nloc) {
            __builtin_amdgcn_fence(__ATOMIC_RELEASE, "agent");
            asm volatile("s_waitcnt vmcnt(0)" ::: "memory");
            const unsigned og = xb_add(&bar[XB_TOP], 1u);
            const unsigned tg = og / nx;
            if (og + 1u == (tg + 1u) * nx) xb_add(&bar[XB_TOPGEN], 1u);
            else XB_SPIN(xb_ld(&bar[XB_TOPGEN]) == tg, bar);
            __builtin_amdgcn_fence(__ATOMIC_ACQUIRE, "agent");
            xb_add(&bar[XB_XGEN(b.x)], 1u);
            asm volatile("s_waitcnt vmcnt(0)" ::: "memory");
        } else {
            XB_SPIN(xb_ld(&bar[XB_XGEN(b.x)]) == gen, bar);
            __builtin_amdgcn_fence(__ATOMIC_ACQUIRE, "agent");
            asm volatile("s_waitcnt vmcnt(0)" ::: "memory");
        }
    }
    __syncthreads();
}

typedef unsigned short bf16;
typedef float f32x4 __attribute__((ext_vector_type(4)));
typedef unsigned v4u __attribute__((ext_vector_type(4)));
typedef unsigned v2u __attribute__((ext_vector_type(2)));
#define LAS __attribute__((address_space(3)))
constexpr int NWAVES = 8, NTHR = 512;
constexpr int DM = 1024, NB = 16, SEQ = 2048, CTX = 256, DFF = 2816, INC = 5632, NMOD = 9;
constexpr int MLAT = NB * SEQ, MCTX = NB * CTX, MALL = MLAT + MCTX;
constexpr int KM = 1536;
constexpr int LDS_BYTES = 139264;
constexpr int LDS_MISC_OFF = 138240;
static_assert(att::LDS_BYTES <= LDS_MISC_OFF && pg8::STAGE_BYTES <= LDS_MISC_OFF && LDS_MISC_OFF + 16 <= LDS_BYTES, "LDS map");

struct Args { const float* in[21]; float* out; unsigned char* ws; int ph_lo, ph_hi; };

__device__ __forceinline__ unsigned f2bf(float f) { unsigned u = __builtin_bit_cast(unsigned, f); return (u + 0x7fffu + ((u >> 16) & 1u)) >> 16; }
__device__ __forceinline__ unsigned pk2(float lo, float hi) { return f2bf(lo) | (f2bf(hi) << 16); }
__device__ __forceinline__ float wave_sum(float v) {
#pragma unroll
    for (int o = 1; o < 64; o <<= 1) v += __shfl_xor(v, o);
    return v;
}
__device__ __forceinline__ int permq(int o) { return 8 * ((o >> 2) & 3) + 4 * (o >> 4) + (o & 3); }
__device__ __forceinline__ void transpose_item(const float* W, int N, bf16* WT, int ldt, int kofs, int k0, int n0, int drow0, LAS float* scr, int lane, bool qk = false) {
#pragma unroll
    for (int i = 0; i < 32; ++i) { const int kk = 2 * i + (lane >> 5); scr[kk * 33 + (lane & 31)] = W[(size_t)(k0 + kk) * N + n0 + (lane & 31)]; }
    asm volatile("s_waitcnt lgkmcnt(0)" ::: "memory");
    const int c = lane & 7;
#pragma unroll
    for (int j = 0; j < 4; ++j) { const int n = (lane >> 3) + 8 * j; const LAS float* s = scr + (8 * c) * 33 + n;
        v4u o; o.x = pk2(s[0 * 33], s[1 * 33]); o.y = pk2(s[2 * 33], s[3 * 33]); o.z = pk2(s[4 * 33], s[5 * 33]); o.w = pk2(s[6 * 33], s[7 * 33]);
        *(v4u*)(WT + (size_t)(drow0 + (qk ? permq(n) : n)) * ldt + kofs + k0 + 8 * c) = o; }
    asm volatile("s_waitcnt lgkmcnt(0)" ::: "memory");
}
__device__ __forceinline__ void adaln_row(const float* xrow, const float* g, const float* shift, const float* scale, bf16* orow, int lane) {
    const f32x4* xr = (const f32x4*)xrow + lane;
    f32x4 v[4]; float s2 = 0.f;
#pragma unroll
    for (int j = 0; j < 4; ++j) { v[j] = xr[64 * j]; s2 += (v[j].x * v[j].x + v[j].y * v[j].y) + (v[j].z * v[j].z + v[j].w * v[j].w); }
    const float rstd = 1.0f / sqrtf(wave_sum(s2) * (1.f / DM) + 1e-6f);
    unsigned long long* o8 = (unsigned long long*)orow + lane;
#pragma unroll
    for (int j = 0; j < 4; ++j) { const f32x4 gg = ((const f32x4*)g)[lane + 64 * j], sh = ((const f32x4*)shift)[lane + 64 * j], sc = ((const f32x4*)scale)[lane + 64 * j];
        const f32x4 h = v[j] * rstd * gg * (sc + 1.0f) + sh;
        o8[64 * j] = (unsigned long long)pk2(h.x, h.y) | ((unsigned long long)pk2(h.z, h.w) << 32); }
}


__device__ __forceinline__ void gemv17_item(LAS float* ldsf, const float* v0, int vstride, const float* v16, bool silu, const float* W, int ldw, int ncol0,
                                            const float* addb, float* outp, int out_ld, int ocol0, int nrows, int wave, int lane, int tid, bool qk = false) {
    LAS float* sw = ldsf + wave * (17 * 128);
    LAS float* red = ldsf + 8 * 17 * 128;
    const int kbase = wave * 128, n = ncol0 + lane;
    { float cv[34];
#pragma unroll
      for (int i = 0; i < 34; ++i) { const int idx = lane + 64 * i, b = idx >> 7, kk = idx & 127; cv[i] = (b < 16) ? v0[(size_t)b * vstride + kbase + kk] : v16[kbase + kk]; }
#pragma unroll
      for (int i = 0; i < 34; ++i) sw[lane + 64 * i] = silu ? cv[i] / (1.0f + __expf(-cv[i])) : cv[i]; }
    asm volatile("s_waitcnt lgkmcnt(0)" ::: "memory");
    float a[17];
#pragma unroll
    for (int b = 0; b < 17; ++b) a[b] = 0.f;
    for (int k0 = 0; k0 < 128; k0 += 16) { float wv[16];
#pragma unroll
        for (int kk = 0; kk < 16; ++kk) wv[kk] = W[(size_t)(kbase + k0 + kk) * ldw + n];
#pragma unroll
        for (int kk = 0; kk < 16; ++kk)
#pragma unroll
            for (int b = 0; b < 17; ++b) a[b] += sw[b * 128 + k0 + kk] * wv[kk]; }
#pragma unroll
    for (int b = 0; b < 17; ++b) red[(wave * 17 + b) * 64 + lane] = a[b];
    __syncthreads();
    for (int idx = tid; idx < nrows * 64; idx += NTHR) { const int b = idx >> 6, l = idx & 63; float sacc = 0.f;
#pragma unroll
        for (int w = 0; w < 8; ++w) sacc += red[(w * 17 + b) * 64 + l];
        outp[(size_t)b * out_ld + ocol0 + (qk ? ((l & 32) + permq(l & 31)) : l)] = sacc + (addb ? addb[ncol0 + l] : 0.f); }
    __syncthreads();
}

__global__ void __launch_bounds__(NTHR) fwd_kernel(Args args) {
    extern __shared__ __attribute__((aligned(16))) unsigned char lds[];
    cg::grid_group grid = cg::this_grid();
    const int tid = threadIdx.x, lane = tid & 63, wave = __builtin_amdgcn_readfirstlane(tid >> 6);
    const int G = gridDim.x, bx = blockIdx.x;
    const int gw = bx * NWAVES + wave, NGW = G * NWAVES;
    unsigned char* ws = args.ws;
    const float* x = args.in[0]; const float* cvec = args.in[1]; const float* ctx = args.in[2]; const float* c_ctx = args.in[3];
    const float* w_mod = args.in[4]; const float* b_mod = args.in[5]; const float* g_norm = args.in[6]; const float* w_gu = args.in[7];
    const float* w_down = args.in[8]; const float* w_in = args.in[9]; const float* lq1 = args.in[10]; const float* lk1 = args.in[11];
    const float* lq2 = args.in[12]; const float* lk2 = args.in[13]; const float* g_subln = args.in[14]; const float* w_pool = args.in[15];
    const float* pool_scale = args.in[16]; const float* w_ba = args.in[17]; const float* w_bp = args.in[18]; const float* w_out = args.in[19];
    const float* g_final = args.in[20];
    float* out = args.out;
    float* mod = (float*)(ws + WS_MOD); float* cosT = (float*)(ws + WS_COS); float* sinT = (float*)(ws + WS_SIN); float* lamp = (float*)(ws + WS_LAM);
    bf16* Wgu1 = (bf16*)(ws + WS_WGU1); bf16* Wgu2 = (bf16*)(ws + WS_WGU2); bf16* Wd1 = (bf16*)(ws + WS_WD1); bf16* Wd2 = (bf16*)(ws + WS_WD2);
    bf16* Win = (bf16*)(ws + WS_WIN); bf16* Wm = (bf16*)(ws + WS_WM); bf16* Wout = (bf16*)(ws + WS_WOUT);
    bf16* Abuf = (bf16*)(ws + WS_ABUF); bf16* Amerge = (bf16*)(ws + WS_AMERGE); float* lat1 = (float*)(ws + WS_LAT1);
    bf16* Qb = (bf16*)(ws + WS_Q); bf16* Kb = (bf16*)(ws + WS_K); bf16* Vb = (bf16*)(ws + WS_V); bf16* Ub = (bf16*)(ws + WS_U);
    bf16* Hb = (bf16*)(ws + WS_H); bf16* Yb = (bf16*)(ws + WS_Y); bf16* Gb = (bf16*)out;
    float* rss2 = (float*)(ws + WS_RSS2); float* rss3 = (float*)(ws + WS_RSS3); float* bias2 = (float*)(ws + WS_BIAS2); float* bias3 = (float*)(ws + WS_BIAS3);
    const int lo = args.ph_lo, hi = args.ph_hi;
#define IN(k) (lo <= (k) && (k) < hi)
#define SEAM(k) do { if (IN(k) && hi > (k) + 1) { xcd_barrier(xbar); } } while (0)
    volatile XLAS unsigned* misc = (volatile XLAS unsigned*)((XLAS unsigned char*)lds + LDS_MISC_OFF);
    if (tid < 4) misc[tid] = 0u;
    __syncthreads();
    XcdBarrier xbar; xbar.bar = (unsigned*)(ws + WS_BAR); xbar.x = 0; xbar.st = misc;
    if (hi - lo > 1) {
        for (int i = bx * NTHR + tid; i < XCD_BAR_WORDS; i += G * NTHR) __hip_atomic_store((unsigned*)(ws + WS_BAR) + i, 0u, __ATOMIC_RELAXED, __HIP_MEMORY_SCOPE_AGENT);
        asm volatile("s_waitcnt vmcnt(0)" ::: "memory");
        grid.sync();
        xbar = xcd_barrier_post((unsigned*)(ws + WS_BAR), misc); }
    PG8_LAS unsigned char* glds = (PG8_LAS unsigned char*)lds;

    if (IN(0)) {
        if (bx < 144) gemv17_item((LAS float*)lds, cvec, DM, c_ctx, true, w_mod, NMOD * DM, bx * 64, b_mod, mod, NMOD * DM, bx * 64, 17, wave, lane, tid);
        else { for (int i = (bx - 144) * NTHR + tid; i < MALL + MLAT; i += (G - 144) * NTHR) { if (i < MALL) rss2[i] = 0.f; else rss3[i - MALL] = 0.f; }
            LAS float* scr = (LAS float*)lds + wave * 4096;
            for (int it = (bx - 144) * NWAVES + wave; it < 1792; it += (G - 144) * NWAVES) { const int kb = it / 176, nb = it % 176, n0 = nb * 32; const int isb = n0 >= DFF, j = n0 - isb * DFF;
                transpose_item(w_gu, 2 * DFF, Wgu1, DM, 0, kb * 64, n0, (j >> 7) * 256 + isb * 128 + (j & 127), scr, lane); } }
        if (bx == G - 1) {
            for (int idx = tid; idx < 1024; idx += NTHR) { const int pos = idx >> 4, i = idx & 15; const float freq = exp2f(-(float)i * (13.287712379549449f / 16.0f)); const float ang = (float)pos * freq;
                cosT[idx] = __cosf(ang); sinT[idx] = __sinf(ang); }
            if (wave == 0) { const float s1 = wave_sum(lq1[lane] * lk1[lane]), s2 = wave_sum(lq2[lane] * lk2[lane]); if (lane == 0) lamp[0] = __expf(s1) - __expf(s2) + 0.2f; }
        }
    }
    SEAM(0);
    if (IN(1)) {
        {
            f32x4 v[4], vn[4];
            auto rowsrc = [&](int r) -> const float* { return (r >= MLAT) ? ctx + (size_t)(r - MLAT) * DM : x + (size_t)r * DM; };
            int r = gw;
            if (r < MALL) {
#pragma unroll
                for (int j = 0; j < 4; ++j) v[j] = ((const f32x4*)rowsrc(r))[lane + 64 * j]; }
            for (; r < MALL; r += NGW) {
                const int rn = r + NGW; const bool hasn = rn < MALL;
                if (hasn) {
#pragma unroll
                    for (int j = 0; j < 4; ++j) vn[j] = ((const f32x4*)rowsrc(rn))[lane + 64 * j]; }
                const int brow = (r >= MLAT) ? 16 : (r >> 11); const float* mr = mod + (size_t)brow * (NMOD * DM);
                f32x4 gg[4], sh[4], sc[4];
#pragma unroll
                for (int j = 0; j < 4; ++j) { gg[j] = ((const f32x4*)g_norm)[lane + 64 * j]; sh[j] = ((const f32x4*)mr)[lane + 64 * j]; sc[j] = ((const f32x4*)(mr + DM))[lane + 64 * j]; }
                float s2 = 0.f;
#pragma unroll
                for (int j = 0; j < 4; ++j) s2 += (v[j].x * v[j].x + v[j].y * v[j].y) + (v[j].z * v[j].z + v[j].w * v[j].w);
                const float rstd = 1.0f / sqrtf(wave_sum(s2) * (1.f / DM) + 1e-6f);
                unsigned long long* o8 = (unsigned long long*)(Abuf + (size_t)r * DM) + lane;
#pragma unroll
                for (int j = 0; j < 4; ++j) { const f32x4 h = v[j] * rstd * gg[j] * (sc[j] + 1.0f) + sh[j];
                    o8[64 * j] = (unsigned long long)pk2(h.x, h.y) | ((unsigned long long)pk2(h.z, h.w) << 32); }
#pragma unroll
                for (int j = 0; j < 4; ++j) v[j] = vn[j];
            }
        }
        LAS float* scr = (LAS float*)lds + wave * 4096;
        constexpr int I_GU = 16 * 176;
        for (int it = 1792 + gw; it < I_GU; it += NGW) {
            const int kb = it / 176, nb = it % 176, n0 = nb * 32; const int isb = n0 >= DFF, j = n0 - isb * DFF;
            transpose_item(w_gu, 2 * DFF, Wgu1, DM, 0, kb * 64, n0, (j >> 7) * 256 + isb * 128 + (j & 127), scr, lane); }
    }
    SEAM(1);
    if (IN(2)) { pg8::Gemm g{Abuf, Wgu1, MALL, 2 * DFF, DM, DM, DM}; pg8::StaticOrder S; S.init(MALL, 2 * DFF, G, bx, WGM_W); pg8::EpiSwiglu<false> E{ws};
        pg8::gemm_phase<pg8::EpiSwiglu<false>, pg8::StaticOrder, true, true>(glds, g, S, E);
        if (bx >= 96) { LAS float* scr = (LAS float*)lds + wave * 4096; constexpr int I_D = 44 * 32;
            for (int it = (bx - 96) * NWAVES + wave; it < I_D; it += (G - 96) * NWAVES) { const int kb = it / 32, nb = it % 32; transpose_item(w_down, DM, Wd1, DFF, 0, kb * 64, nb * 32, nb * 32, scr, lane); } }
    }
    SEAM(2);
    if (IN(3)) { pg8::Gemm g{Hb, Wd1, MALL, DM, DFF, DFF, DFF}; pg8::StaticOrder S; S.init(MALL, DM, G, bx, WGM_N); pg8::EpiResid<true, 2, 4, 1> E{x, ctx, lat1, ws, g_norm + DM};
        pg8::gemm_phase<pg8::EpiResid<true, 2, 4, 1>, pg8::StaticOrder, true, true>(glds, g, S, E);
        if (bx >= 64) {
            LAS float* scr = (LAS float*)lds + wave * 4096;
            constexpr int I_GU = 16 * 176, I_D = 44 * 32, I_SQ = 16 * 32, I_IN = 16 * 176;
            for (int it = (bx - 64) * NWAVES + wave; it < I_IN + I_GU + I_D + 2 * I_SQ; it += (G - 64) * NWAVES) {
                int r = it;
                if (r < I_IN) { const int kb = r / 176, nb = r % 176; transpose_item(w_in, INC, Win, DM, 0, kb * 64, nb * 32, nb * 32, scr, lane, nb < 64); continue; }
                r -= I_IN;
                if (r < I_GU) { const int kb = r / 176, nb = r % 176, n0 = nb * 32; const int isb = n0 >= DFF, j = n0 - isb * DFF;
                    transpose_item(w_gu + (size_t)DM * 2 * DFF, 2 * DFF, Wgu2, DM, 0, kb * 64, n0, (j >> 7) * 256 + isb * 128 + (j & 127), scr, lane); continue; }
                r -= I_GU;
                if (r < I_D) { const int kb = r / 32, nb = r % 32; transpose_item(w_down + (size_t)DFF * DM, DM, Wd2, DFF, 0, kb * 64, nb * 32, nb * 32, scr, lane); continue; }
                r -= I_D;
                if (r < I_SQ) { const int kb = r / 32, nb = r % 32; transpose_item(w_ba, DM, Wm, KM, 0, kb * 64, nb * 32, nb * 32, scr, lane); continue; }
                r -= I_SQ;
                { const int kb = r / 32, nb = r % 32; transpose_item(w_out, DM, Wout, DM, 0, kb * 64, nb * 32, nb * 32, scr, lane); }
            }
            { const int item = (bx - 64) * NTHR + tid;
              if (item < 4 * 16 * 1024) { const int n = item & 1023, ib = (item >> 10) & 15, g = item >> 14;
                float a[8];
#pragma unroll
                for (int ii = 0; ii < 8; ++ii) a[ii] = 0.f;
                for (int j0 = 0; j0 < 128; j0 += 16) { float wv[16];
#pragma unroll
                    for (int jj = 0; jj < 16; ++jj) wv[jj] = pool_scale[g * 128 + j0 + jj] * w_bp[(size_t)(g * 128 + j0 + jj) * DM + n];
#pragma unroll
                    for (int jj = 0; jj < 16; ++jj)
#pragma unroll
                        for (int ii = 0; ii < 8; ++ii) a[ii] += w_pool[(size_t)(g * 128 + ib * 8 + ii) * 128 + j0 + jj] * wv[jj]; }
                v4u o; o.x = pk2(a[0], a[1]); o.y = pk2(a[2], a[3]); o.z = pk2(a[4], a[5]); o.w = pk2(a[6], a[7]);
                *(v4u*)(Wm + (size_t)n * KM + 1024 + g * 128 + ib * 8) = o; } }
            __syncthreads();
            if (bx < 64 + 176) { const int bi = bx - 64, which = bi / 88, it = bi % 88, n0 = it * 64;
                if (which == 0) gemv17_item((LAS float*)lds, mod + 3 * DM, NMOD * DM, mod + (size_t)16 * NMOD * DM + 3 * DM, false, w_in, INC, n0, nullptr, bias2, INC, n0, 17, wave, lane, tid, n0 < 2048);
                else { const int isb = n0 >= DFF, j = n0 - isb * DFF;
                    gemv17_item((LAS float*)lds, mod + 6 * DM, NMOD * DM, mod + (size_t)16 * NMOD * DM + 6 * DM, false, w_gu + (size_t)DM * 2 * DFF, 2 * DFF, n0, nullptr, bias3, INC, (j >> 7) * 256 + isb * 128 + (j & 127), 16, wave, lane, tid); } }
        }
    }
    SEAM(3);
    if (IN(5)) {
        { pg8::Gemm g{Abuf, Win, MLAT, INC, DM, DM, DM}; pg8::StaticOrder S; S.init(MLAT, INC, G, bx, WGM_W); pg8::EpiProj E{ws, Gb, 0};
          pg8::gemm_phase<pg8::EpiProj, pg8::StaticOrder, true, true>(glds, g, S, E); }
        { pg8::Gemm g{Abuf + (size_t)MLAT * DM, Win + (size_t)1024 * DM, MCTX, 2048, DM, DM, DM}; pg8::StaticOrder S; S.init(MCTX, 2048, G, bx, WGM_W); pg8::EpiProj E{ws, Gb, 1};
          pg8::gemm_phase<pg8::EpiProj, pg8::StaticOrder, true, true>(glds, g, S, E); }
    }
    SEAM(5);
    if (IN(6)) {
        for (int r = gw; r < MLAT; r += NGW) { const int t = r & (SEQ - 1); const int g = lane >> 4, hw = 1 << g;
            const bf16* up = Ub + (size_t)r * 512 + lane * 8;
            const int tlo = (t - hw) < 0 ? 0 : (t - hw), thi = (t + hw) > SEQ ? SEQ : (t + hw);
            v4u u[16];
#pragma unroll
            for (int i = 0; i < 16; ++i) { const int tt = t + i - 8; const bool ok = (tt >= tlo) && (tt < thi); u[i] = ok ? *(const v4u*)(up + (ptrdiff_t)(i - 8) * 512) : (v4u){0u, 0u, 0u, 0u}; }
            float a[8];
#pragma unroll
            for (int i = 0; i < 8; ++i) a[i] = 0.f;
#pragma unroll
            for (int i = 0; i < 16; ++i) { a[0] += pg8::bf_lo(u[i].x); a[1] += pg8::bf_hi(u[i].x); a[2] += pg8::bf_lo(u[i].y); a[3] += pg8::bf_hi(u[i].y);
                a[4] += pg8::bf_lo(u[i].z); a[5] += pg8::bf_hi(u[i].z); a[6] += pg8::bf_lo(u[i].w); a[7] += pg8::bf_hi(u[i].w); }
            const float inv = 1.0f / (float)(thi - tlo); const v4u u0 = u[8];
            v4u o; o.x = pk2(a[0] * inv - pg8::bf_lo(u0.x), a[1] * inv - pg8::bf_hi(u0.x)); o.y = pk2(a[2] * inv - pg8::bf_lo(u0.y), a[3] * inv - pg8::bf_hi(u0.y));
            o.z = pk2(a[4] * inv - pg8::bf_lo(u0.z), a[5] * inv - pg8::bf_hi(u0.z)); o.w = pk2(a[6] * inv - pg8::bf_lo(u0.w), a[7] * inv - pg8::bf_hi(u0.w));
            *(v4u*)(Amerge + (size_t)r * KM + 1024 + lane * 8) = o; }
        __syncthreads();
        const float lam = lamp[0];
        const int vcu = (G % 8 == 0) ? (bx % 8) * (G / 8) + bx / 8 : bx;
        for (int un = vcu; un < NB * 8 * 16; un += G) { const int bh = un >> 4, qb = un & 15, b = bh >> 3, h = bh & 7;
            att::diff_attn_unit(Qb + (size_t)(b * SEQ + qb * 128) * DM + h * 128, Kb + (size_t)b * att::SKV * DM + h * 128, Vb + (size_t)b * att::SKV * DM + h * 128,
                                Amerge + (size_t)(b * SEQ + qb * 128) * KM + h * 128, g_subln, lam, 0.8f, (char*)lds); }
    }
    SEAM(6);
    if (IN(7)) {
        { pg8::Gemm g{Amerge, Wm, MLAT, DM, 1024, KM, KM}; pg8::StaticOrder S; S.init(MLAT, DM, G, bx, WGM_N); pg8::EpiMerge<false> E{Gb, Yb};
          pg8::gemm_phase<pg8::EpiMerge<false>, pg8::StaticOrder, true, true>(glds, g, S, E); }
        { pg8::Gemm g{Amerge + 1024, Wm + 1024, MLAT, DM, 512, KM, KM}; pg8::StaticOrder S; S.init(MLAT, DM, G, bx, WGM_N); pg8::EpiMerge<true> E{Gb, Yb};
          pg8::gemm_phase<pg8::EpiMerge<true>, pg8::StaticOrder, true, true>(glds, g, S, E); }
    }
    SEAM(7);
    if (IN(8)) { pg8::Gemm g{Yb, Wout, MLAT, DM, DM, DM, DM}; pg8::StaticOrder S; S.init(MLAT, DM, G, bx, WGM_N); pg8::EpiResid<true, 5, 7, 0> E{lat1, lat1, out, ws, g_norm + 2 * DM};
        pg8::gemm_phase<pg8::EpiResid<true, 5, 7, 0>, pg8::StaticOrder, true, true>(glds, g, S, E); }
    SEAM(8);
    if (IN(10)) { pg8::Gemm g{Abuf, Wgu2, MLAT, 2 * DFF, DM, DM, DM}; pg8::StaticOrder S; S.init(MLAT, 2 * DFF, G, bx, WGM_W); pg8::EpiSwiglu<true> E{ws};
        pg8::gemm_phase<pg8::EpiSwiglu<true>, pg8::StaticOrder, true, true>(glds, g, S, E); }
    SEAM(10);
    if (IN(11)) { pg8::Gemm g{Hb, Wd2, MLAT, DM, DFF, DFF, DFF}; pg8::StaticOrder S; S.init(MLAT, DM, G, bx, WGM_N); pg8::EpiResid<false, 8, 0, 1> E{out, out, out, ws, nullptr};
        pg8::gemm_phase<pg8::EpiResid<false, 8, 0, 1>, pg8::StaticOrder, true, true>(glds, g, S, E); }
    SEAM(11);
    if (IN(12)) {
        f32x4 v[4], vn[4], gf[4];
#pragma unroll
        for (int j = 0; j < 4; ++j) gf[j] = ((const f32x4*)g_final)[lane + 64 * j];
        int r = gw;
        if (r < MLAT) {
#pragma unroll
            for (int j = 0; j < 4; ++j) v[j] = ((const f32x4*)(out + (size_t)r * DM))[lane + 64 * j]; }
        for (; r < MLAT; r += NGW) {
            const int rn = r + NGW;
            if (rn < MLAT) {
#pragma unroll
                for (int j = 0; j < 4; ++j) vn[j] = ((const f32x4*)(out + (size_t)rn * DM))[lane + 64 * j]; }
            float s2 = 0.f;
#pragma unroll
            for (int j = 0; j < 4; ++j) s2 += (v[j].x * v[j].x + v[j].y * v[j].y) + (v[j].z * v[j].z + v[j].w * v[j].w);
            const float rstd = 1.0f / sqrtf(wave_sum(s2) * (1.f / DM) + 1e-6f);
            f32x4* xr = (f32x4*)(out + (size_t)r * DM) + lane;
#pragma unroll
            for (int j = 0; j < 4; ++j) xr[64 * j] = v[j] * rstd * gf[j];
#pragma unroll
            for (int j = 0; j < 4; ++j) v[j] = vn[j];
        }
    }
#undef IN
#undef SEAM
}

extern "C" void kernel_launch(void* const* d_in, const int* in_sizes, int n_in, void* d_out, int out_size, void* d_ws, size_t ws_size, hipStream_t stream) {
    static int grid = 0;
    if (grid == 0) {
        if (n_in != 21 || out_size != MLAT * DM || ws_size < WS_END) { fprintf(stderr, "kernel_launch: unexpected shapes (n_in %d out %d ws %zu)\n", n_in, out_size, ws_size); grid = -1; return; }
        int dev = 0, cus = 0, per_cu = 0;
        hipGetDevice(&dev); hipDeviceGetAttribute(&cus, hipDeviceAttributeMultiprocessorCount, dev);
        if (hipFuncSetAttribute((const void*)fwd_kernel, hipFuncAttributeMaxDynamicSharedMemorySize, LDS_BYTES) != hipSuccess) { fprintf(stderr, "kernel_launch: hipFuncSetAttribute failed\n"); grid = -1; return; }
        if (hipOccupancyMaxActiveBlocksPerMultiprocessor(&per_cu, (const void*)fwd_kernel, NTHR, LDS_BYTES) != hipSuccess || per_cu < 1) { fprintf(stderr, "kernel_launch: occupancy query says %d\n", per_cu); per_cu = 1; }
        (void)hipGetLastError();
        grid = cus * 1;
    }
    if (grid < 0) return;
    Args a{};
    for (int i = 0; i < 21; ++i) a.in[i] = (const float*)d_in[i];
    a.out = (float*)d_out; a.ws = (unsigned char*)d_ws;
#if MK_MULTI
    for (int p = 0; p < 13; ++p) { a.ph_lo = p; a.ph_hi = p + 1; hipLaunchKernelGGL(fwd_kernel, dim3(grid), dim3(NTHR), LDS_BYTES, stream, a); }
#else
    a.ph_lo = 0; a.ph_hi = 13;
    void* kargs[] = {&a};
    hipError_t e = hipLaunchCooperativeKernel((const void*)fwd_kernel, dim3(grid), dim3(NTHR), kargs, LDS_BYTES, stream);
    if (e != hipSuccess) fprintf(stderr, "kernel_launch: cooperative launch failed: %s (grid %d)\n", hipGetErrorString(e), grid);
#endif
}
```

```cpp
#include <hip/hip_runtime.h>
#include <hip/hip_cooperative_groups.h>
#include <cstdio>
#include <cstdint>
namespace cg = cooperative_groups;

#ifndef WGM_W
#define WGM_W 4
#endif
#ifndef WGM_N
#define WGM_N 2
#endif
#ifndef MK_MULTI
#define MK_MULTI 0
#endif

constexpr size_t MiB = 1u << 20;
constexpr size_t WS_MOD = 0, WS_COS = 640 * 1024, WS_SIN = 644 * 1024, WS_LAM = 648 * 1024, WS_BAR = 704 * 1024, BAR_BYTES = 16 * 1024;
constexpr size_t WS_RSS2 = 23 * MiB, WS_RSS3 = 23 * MiB + 144 * 1024, WS_BIAS2 = 23 * MiB + 272 * 1024, WS_BIAS3 = 23 * MiB + 656 * 1024;
constexpr size_t WS_WGU2 = 1 * MiB, WS_WD2 = 12 * MiB, WS_WM = 18 * MiB, WS_WOUT = 21 * MiB;
constexpr size_t WS_WGU1 = 24 * MiB, WS_WD1 = 35 * MiB, WS_WIN = 41 * MiB, WS_ABUF = 52 * MiB;
constexpr size_t WS_AMERGE = 24 * MiB;
constexpr size_t WS_LAT1 = 124 * MiB, WS_R = 268 * MiB;
constexpr size_t WS_Q = WS_R, WS_K = WS_R + 64 * MiB, WS_V = WS_R + 136 * MiB, WS_U = WS_R + 208 * MiB, WS_H = WS_R, WS_Y = WS_R;
constexpr size_t WS_END = 508 * MiB;

namespace pg8 {
#define PG8_LAS __attribute__((address_space(3)))
typedef unsigned short bf16_t;
typedef short bf16x8 __attribute__((ext_vector_type(8)));
typedef float f32x4 __attribute__((ext_vector_type(4)));
typedef unsigned u32x4 __attribute__((ext_vector_type(4)));
typedef unsigned u32x2 __attribute__((ext_vector_type(2)));
constexpr int BM = 256, BK = 64, HALF = 128, HTB = HALF * BK * 2, STAGE_BYTES = 8 * HTB, NXCD = 8, WGM = 8;

__host__ __device__ __forceinline__ int lds_byte(int r, int c) { const int st = (r >> 4) * 2 + (c >> 5), rr = r & 15, cc = c & 31, ob = rr * 64 + cc * 2; return st * 1024 + (ob ^ (((ob >> 9) & 1) << 5)); }
__host__ __device__ __forceinline__ void stage_rc(int b, int& R, int& C) { const int st = b / 1024, sb = b % 1024, swz = sb ^ (((sb >> 9) & 1) << 5); R = (st >> 1) * 16 + swz / 64; C = (st & 1) * 32 + (swz % 64) / 2; }
__host__ __device__ __forceinline__ int perm32(int rho) { const int n = rho >> 4, i = rho & 15; return 8 * (i >> 2) + 4 * n + (i & 3); }

struct Unit { int pm, pn; };
struct Gemm { const bf16_t* A; const bf16_t* Bt; int M, N, K, lda, ldb; };

struct StaticOrder {
    int nM, nN, nwg, G, c, wgm;
    __host__ __device__ void init(int M, int N, int G_, int c_, int wgm_ = 4) { nM = M / BM; nN = N / BM; nwg = nM * nN; G = G_; c = c_; wgm = wgm_; }
    __host__ __device__ bool next(int i, Unit& u) const {
        const long L = (long)i * G + c; if (L >= nwg) return false;
        int wgid = (int)L; { const int q = nwg / NXCD, r = nwg % NXCD, xcd = wgid % NXCD, off = wgid / NXCD; wgid = (xcd < r ? xcd * (q + 1) : r * (q + 1) + (xcd - r) * q) + off; }
        const int nig = wgm * nN, gid = wgid / nig, fm = gid * wgm, gsz = (nM - fm) < wgm ? (nM - fm) : wgm;
        u.pm = fm + ((wgid % nig) % gsz); u.pn = (wgid % nig) / gsz; return true;
    }
    __device__ __forceinline__ void a_ready(const Unit&) const {}
    __device__ __forceinline__ void done(const Unit&) const {}
};

__device__ __forceinline__ unsigned cvt_pk_bf16(float lo, float hi) { unsigned r; asm volatile("v_cvt_pk_bf16_f32 %0, %1, %2" : "=v"(r) : "v"(lo), "v"(hi)); return r; }
__device__ __forceinline__ float bf_lo(unsigned w) { return __uint_as_float(w << 16); }
__device__ __forceinline__ float bf_hi(unsigned w) { return __uint_as_float(w & 0xffff0000u); }
__device__ __forceinline__ float fast_sigmoid(float v) { return __builtin_amdgcn_rcpf(1.0f + __builtin_amdgcn_exp2f(-1.4426950408889634f * v)); }


template <bool FOLD> struct EpiSwiglu {
    static constexpr bool PERM = true, AFTER_DRAIN = false, HAS_MID = false; static constexpr int MID_T = -1;
    unsigned char* ws;
    __device__ __forceinline__ void operator()(const f32x4 (&acc)[2][2][4][2], const Unit& u, int wr, int wc, int fr, int fq) const {
        const int row0 = u.pm * BM + wr * 64 + fr, col0 = u.pn * HALF + wc * 32 + 8 * fq;
        bf16_t* O = (bf16_t*)(ws + WS_H); constexpr int ldc = 2816; const float* rowss = (const float*)(ws + WS_RSS3); const float* bias = (const float*)(ws + WS_BIAS3);
        f32x4 bv[2][2];
        if (FOLD) { const float* bp = bias + (size_t)(u.pm >> 3) * 5632 + u.pn * BM + wc * 32 + 8 * fq;
#pragma unroll
            for (int bj = 0; bj < 2; ++bj)
#pragma unroll
                for (int n = 0; n < 2; ++n) bv[bj][n] = *(const f32x4*)(bp + bj * HALF + 4 * n); }
#pragma unroll
        for (int ai = 0; ai < 2; ++ai)
#pragma unroll
            for (int m = 0; m < 4; ++m) { const int r = row0 + ai * HALF + m * 16; bf16_t* rowp = O + (size_t)r * ldc + col0;
                float rstd = 1.f; if (FOLD) rstd = __builtin_amdgcn_rsqf(rowss[r] * (1.f / 1024.f) + 1e-6f);
                f32x4 h[2];
#pragma unroll
                for (int n = 0; n < 2; ++n) { f32x4 a = acc[ai][0][m][n], b = acc[ai][1][m][n];
                    if (FOLD) { a = a * rstd + bv[0][n]; b = b * rstd + bv[1][n]; }
#pragma unroll
                    for (int j = 0; j < 4; ++j) h[n][j] = a[j] * fast_sigmoid(a[j]) * b[j]; }
                u32x4 w; w.x = cvt_pk_bf16(h[0][0], h[0][1]); w.y = cvt_pk_bf16(h[0][2], h[0][3]); w.z = cvt_pk_bf16(h[1][0], h[1][1]); w.w = cvt_pk_bf16(h[1][2], h[1][3]);
                *(u32x4*)rowp = w; }
    }
};

template <bool NEXT, int gidx, int sidx, int HALFS> struct EpiResid {
    static constexpr bool PERM = false, AFTER_DRAIN = false, HAS_MID = false; static constexpr int MID_T = -1;
    const float* base_lat; const float* base_ctx; float* out; unsigned char* ws; const float* gn;
    __device__ __forceinline__ void operator()(const f32x4 (&acc)[2][2][4][2], const Unit& u, int wr, int wc, int fr, int fq) const {
        const int col0 = u.pn * BM + wc * 32 + 4 * fq;
        const float* mod = (const float*)(ws + WS_MOD); bf16_t* An = (bf16_t*)(ws + WS_ABUF); float* rowss = (float*)(ws + (sidx == 4 ? WS_RSS2 : WS_RSS3)); constexpr float s = HALFS ? 0.5f : 1.0f;
        const bool isctx = u.pm >= 128; const int brow = isctx ? 16 : (u.pm >> 3);
        const float* mrow = mod + (size_t)brow * 9216 + col0;
        const float* base = isctx ? base_ctx + (size_t)(u.pm - 128) * BM * 1024 : base_lat + (size_t)u.pm * BM * 1024;
        float* outp = out + (size_t)u.pm * BM * 1024;
        f32x4 gv[2][2], wv[2][2];
#pragma unroll
        for (int bj = 0; bj < 2; ++bj)
#pragma unroll
            for (int n = 0; n < 2; ++n) { gv[bj][n] = *(const f32x4*)(mrow + gidx * 1024 + bj * HALF + n * 16) * s;
                if (NEXT) wv[bj][n] = *(const f32x4*)(gn + col0 + bj * HALF + n * 16) * (*(const f32x4*)(mrow + sidx * 1024 + bj * HALF + n * 16) + 1.0f); }
#pragma unroll
        for (int ai = 0; ai < 2; ++ai)
#pragma unroll
            for (int m = 0; m < 4; ++m) { const int rl = ai * HALF + wr * 64 + m * 16 + fr; const size_t off = (size_t)rl * 1024 + col0; float ss = 0.f;
#pragma unroll
                for (int bj = 0; bj < 2; ++bj)
#pragma unroll
                    for (int n = 0; n < 2; ++n) { const f32x4 bs = *(const f32x4*)(base + off + bj * HALF + n * 16); const f32x4 o = bs + gv[bj][n] * acc[ai][bj][m][n];
                        *(f32x4*)(outp + off + bj * HALF + n * 16) = o;
                        if (NEXT) { ss += (o[0] * o[0] + o[1] * o[1]) + (o[2] * o[2] + o[3] * o[3]); const f32x4 a = o * wv[bj][n];
                            u32x2 w; w.x = cvt_pk_bf16(a[0], a[1]); w.y = cvt_pk_bf16(a[2], a[3]); *(u32x2*)(An + (size_t)u.pm * BM * 1024 + off + bj * HALF + n * 16) = w; } }
                if (NEXT) { ss += __shfl_xor(ss, 16); ss += __shfl_xor(ss, 32);
                    if (fq == 0) (void)__hip_atomic_fetch_add(rowss + u.pm * BM + rl, ss, __ATOMIC_RELAXED, __HIP_MEMORY_SCOPE_AGENT); }
                if (m == 3) asm volatile("" ::: "memory"); }
    }
};

struct EpiProj {
    static constexpr bool PERM = true, AFTER_DRAIN = false, HAS_MID = false; static constexpr int MID_T = -1;
    unsigned char* ws; bf16_t* G; int is_ctx;
    __device__ __forceinline__ void operator()(const f32x4 (&acc)[2][2][4][2], const Unit& u, int wr, int wc, int fr, int fq) const {
        bf16_t* Q = (bf16_t*)(ws + WS_Q); bf16_t* K = (bf16_t*)(ws + WS_K); bf16_t* V = (bf16_t*)(ws + WS_V); bf16_t* U = (bf16_t*)(ws + WS_U);
        const float* cosT = (const float*)(ws + WS_COS); const float* sinT = (const float*)(ws + WS_SIN); const float* rowss = (const float*)(ws + WS_RSS2); const float* bias = (const float*)(ws + WS_BIAS2);
        int type, colt;
        if (is_ctx) { type = u.pn < 4 ? 1 : 2; colt = (u.pn & 3) * BM; }
        else { if (u.pn < 4) { type = 0; colt = u.pn * BM; } else if (u.pn < 8) { type = 1; colt = (u.pn - 4) * BM; } else if (u.pn < 12) { type = 2; colt = (u.pn - 8) * BM; }
               else if (u.pn < 14) { type = 3; colt = (u.pn - 12) * BM; } else { type = 4; colt = (u.pn - 14) * BM; } }
        const bool rope = (!is_ctx) && type < 2;
        const int cbase = colt + wc * 32 + 8 * fq;
        f32x4 bv[2][2];
        { const float* bp = bias + (size_t)(is_ctx ? 16 : (u.pm >> 3)) * 5632 + (is_ctx ? 1024 : 0) + u.pn * BM + wc * 32 + 8 * fq;
#pragma unroll
          for (int bj = 0; bj < 2; ++bj)
#pragma unroll
              for (int n = 0; n < 2; ++n) bv[bj][n] = *(const f32x4*)(bp + bj * HALF + n * 4); }
#pragma unroll
        for (int ai = 0; ai < 2; ++ai)
#pragma unroll
            for (int m = 0; m < 4; ++m) {
                const int r = u.pm * BM + ai * HALF + wr * 64 + m * 16 + fr;
                const int kvrow = is_ctx ? ((r >> 8) * 2304 + (r & 255)) : ((r >> 11) * 2304 + 256 + (r & 2047));
                const float rstd = __builtin_amdgcn_rsqf(rowss[(is_ctx ? 32768 : 0) + r] * (1.f / 1024.f) + 1e-6f);
                bf16_t* dst;
                if (type == 0) dst = Q + (size_t)r * 1024; else if (type == 1) dst = K + (size_t)kvrow * 1024; else if (type == 2) dst = V + (size_t)kvrow * 1024;
                else if (type == 3) dst = U + (size_t)r * 512; else dst = G + (size_t)r * 2048;
                dst += cbase;
                f32x4 cs = {1.f, 1.f, 1.f, 1.f}, sn = {0.f, 0.f, 0.f, 0.f};
                if (rope) { const int pos = (wc & 1) ? (r & 63) : ((r >> 6) & 31); cs = *(const f32x4*)(cosT + pos * 16 + 4 * fq); sn = *(const f32x4*)(sinT + pos * 16 + 4 * fq); }
#pragma unroll
                for (int bj = 0; bj < 2; ++bj) { f32x4 v0 = acc[ai][bj][m][0] * rstd + bv[bj][0], v1 = acc[ai][bj][m][1] * rstd + bv[bj][1];
                    if (rope) { const f32x4 o0 = v0 * cs - v1 * sn, o1 = v1 * cs + v0 * sn; v0 = o0; v1 = o1; }
                    if (type == 4) {
#pragma unroll
                        for (int j = 0; j < 4; ++j) { v0[j] = fast_sigmoid(v0[j]); v1[j] = fast_sigmoid(v1[j]); } }
                    u32x4 w; w.x = cvt_pk_bf16(v0[0], v0[1]); w.y = cvt_pk_bf16(v0[2], v0[3]); w.z = cvt_pk_bf16(v1[0], v1[1]); w.w = cvt_pk_bf16(v1[2], v1[3]);
                    *(u32x4*)(dst + bj * HALF) = w; }
            }
    }
};

template <bool SECOND> struct EpiMerge {
    static constexpr bool PERM = true, AFTER_DRAIN = false, HAS_MID = false; static constexpr int MID_T = -1;
    const bf16_t* G; bf16_t* Y;
    __device__ __forceinline__ void operator()(const f32x4 (&acc)[2][2][4][2], const Unit& u, int wr, int wc, int fr, int fq) const {
        const int row0 = u.pm * BM + wr * 64 + fr, col0 = u.pn * BM + wc * 32 + 8 * fq;
#pragma unroll
        for (int ai = 0; ai < 2; ++ai)
#pragma unroll
            for (int m = 0; m < 4; ++m) { const size_t rr = (size_t)(row0 + ai * HALF + m * 16);
#pragma unroll
                for (int bj = 0; bj < 2; ++bj) { const u32x4 p = *(const u32x4*)(G + rr * 2048 + (SECOND ? 1024 : 0) + col0 + bj * HALF);
                    f32x4 v0 = acc[ai][bj][m][0], v1 = acc[ai][bj][m][1];
                    v0[0] *= bf_lo(p.x); v0[1] *= bf_hi(p.x); v0[2] *= bf_lo(p.y); v0[3] *= bf_hi(p.y); v1[0] *= bf_lo(p.z); v1[1] *= bf_hi(p.z); v1[2] *= bf_lo(p.w); v1[3] *= bf_hi(p.w);
                    bf16_t* yp = Y + rr * 1024 + col0 + bj * HALF;
                    if (SECOND) { const u32x4 y = *(const u32x4*)yp;
                        v0[0] += bf_lo(y.x); v0[1] += bf_hi(y.x); v0[2] += bf_lo(y.y); v0[3] += bf_hi(y.y); v1[0] += bf_lo(y.z); v1[1] += bf_hi(y.z); v1[2] += bf_lo(y.w); v1[3] += bf_hi(y.w); }
                    u32x4 w; w.x = cvt_pk_bf16(v0[0], v0[1]); w.y = cvt_pk_bf16(v0[2], v0[3]); w.z = cvt_pk_bf16(v1[0], v1[1]); w.w = cvt_pk_bf16(v1[2], v1[3]);
                    *(u32x4*)yp = w; }
                asm volatile("" ::: "memory"); }
    }
};

template <class Epi, class Sched, bool ALIGN_EPI = false, bool SP2 = false>
__device__ __forceinline__ void gemm_phase(PG8_LAS unsigned char* lds, const Gemm g, const Sched& S, const Epi& E) {
    const int tid = threadIdx.x, wid = __builtin_amdgcn_readfirstlane(tid >> 6), lane = tid & 63, wr = wid >> 2, wc = wid & 3, fr = lane & 15, fq = lane >> 4;
    const int K = g.K, nt = K / BK;
    unsigned voffA[2], voffB[2];
#pragma unroll
    for (int i = 0; i < 2; ++i) { int R, C; stage_rc(tid * 16 + i * 8192, R, C); const int Rb = Epi::PERM ? ((R & ~31) + perm32(R & 31)) : R;
        voffA[i] = (unsigned)(R * g.lda + C) * 2u; voffB[i] = (unsigned)(Rb * g.ldb + C) * 2u; }
    const size_t kstep = (size_t)(BK * 2);
    const size_t hstepA = (size_t)HALF * g.lda * 2, hstepB = (size_t)HALF * g.ldb * 2;
    const size_t tstepA = 2 * hstepA, tstepB = 2 * hstepB;
    const unsigned ldsw = (unsigned)wid * 1024u;
    const int aoff = lds_byte(wr * 64 + fr, fq * 8), boff = lds_byte(wc * 32 + fr, fq * 8);
#define PG8_SA(b, h) (((b) * 2 + (h)) * HTB)
#define PG8_SB(b, h) ((4 + (b) * 2 + (h)) * HTB)
#define PG8_STAGE(bufoff, gbase, voff) do { _Pragma("unroll") for (int _i = 0; _i < 2; ++_i) \
        __builtin_amdgcn_global_load_lds((const unsigned*)((const char*)(gbase) + (voff)[_i]), (PG8_LAS unsigned*)(lds + (bufoff) + ldsw + _i * 8192), 16, 0, 0); } while (0)
#define PG8_LDA(dst, b, h) do { _Pragma("unroll") for (int m = 0; m < 4; ++m) _Pragma("unroll") for (int k = 0; k < 2; ++k) dst[m][k] = *(const PG8_LAS bf16x8*)(lds + PG8_SA(b, h) + aoff + m * 2048 + k * 1024); } while (0)
#define PG8_LDB(dst, b, h) do { _Pragma("unroll") for (int n = 0; n < 2; ++n) _Pragma("unroll") for (int k = 0; k < 2; ++k) dst[n][k] = *(const PG8_LAS bf16x8*)(lds + PG8_SB(b, h) + boff + n * 2048 + k * 1024); } while (0)
#define PG8_MMA(ai, bj, At, Bt) do { __builtin_amdgcn_s_setprio(1); _Pragma("unroll") for (int m = 0; m < 4; ++m) _Pragma("unroll") for (int n = 0; n < 2; ++n) _Pragma("unroll") for (int k = 0; k < 2; ++k) \
        acc[ai][bj][m][n] = __builtin_amdgcn_mfma_f32_16x16x32_bf16(Bt[n][k], At[m][k], acc[ai][bj][m][n], 0, 0, 0); __builtin_amdgcn_s_setprio(0); } while (0)
#define PG8_WAIT_V(n) asm volatile("s_waitcnt vmcnt(" #n ")" ::: "memory")
#define PG8_WAIT_L(n) asm volatile("s_waitcnt lgkmcnt(" #n ")" ::: "memory")
#define PG8_BAR __builtin_amdgcn_s_barrier()
#define PG8_SCHED __builtin_amdgcn_sched_barrier(0)
    Unit cur, nxt; int ui = 0;
    if (!S.next(0, cur)) return;
    f32x4 acc[2][2][4][2];
#pragma unroll
    for (int a = 0; a < 2; ++a)
#pragma unroll
        for (int b = 0; b < 2; ++b)
#pragma unroll
            for (int m = 0; m < 4; ++m)
#pragma unroll
                for (int n = 0; n < 2; ++n) acc[a][b][m][n] = (f32x4){0.f, 0.f, 0.f, 0.f};
    bf16x8 At[4][2], B0[2][2], B1[2][2];
    const char* cA = (const char*)g.A + (size_t)cur.pm * tstepA; const char* cB = (const char*)g.Bt + (size_t)cur.pn * tstepB;
    S.a_ready(cur);
    if constexpr (SP2) {
        PG8_STAGE(PG8_SB(0, 0), cB, voffB); PG8_STAGE(PG8_SB(0, 1), cB + hstepB, voffB); PG8_STAGE(PG8_SA(0, 0), cA, voffA); PG8_STAGE(PG8_SA(0, 1), cA + hstepA, voffA);
        if (wr == 1) PG8_BAR;
        PG8_WAIT_V(2); PG8_BAR;
        PG8_STAGE(PG8_SB(1, 0), cB + kstep, voffB); PG8_STAGE(PG8_SA(1, 0), cA + kstep, voffA); PG8_STAGE(PG8_SB(1, 1), cB + hstepB + kstep, voffB);
        PG8_WAIT_V(6); PG8_BAR;
    } else {
        PG8_STAGE(PG8_SB(0, 0), cB, voffB); PG8_STAGE(PG8_SA(0, 0), cA, voffA); PG8_STAGE(PG8_SB(0, 1), cB + hstepB, voffB); PG8_STAGE(PG8_SA(0, 1), cA + hstepA, voffA);
        if (wr == 1) PG8_BAR;
        PG8_WAIT_V(4); PG8_BAR;
        PG8_STAGE(PG8_SB(1, 0), cB + kstep, voffB); PG8_STAGE(PG8_SA(1, 0), cA + kstep, voffA); PG8_STAGE(PG8_SB(1, 1), cB + hstepB + kstep, voffB);
        PG8_WAIT_V(6); PG8_BAR;
    }
    for (;;) {
        const bool has_next = S.next(ui + 1, nxt);
        const char* nA = has_next ? (const char*)g.A + (size_t)nxt.pm * tstepA : cA; const char* nB = has_next ? (const char*)g.Bt + (size_t)nxt.pn * tstepB : cB;
        for (int t = 0; t < nt; t += 2) {
            const bool last = (t == nt - 2);
            const char* a1 = cA + (size_t)(t + 1) * kstep;
            const char* a2 = last ? nA : cA + (size_t)(t + 2) * kstep; const char* b2 = last ? nB : cB + (size_t)(t + 2) * kstep;
            const char* a3 = a2 + kstep; const char* b3 = b2 + kstep;
            if (last && has_next) S.a_ready(nxt);
            if constexpr (SP2) {
            PG8_LDB(B0, 0, 0); PG8_LDB(B1, 0, 1); PG8_SCHED; PG8_LDA(At, 0, 0); PG8_STAGE(PG8_SA(1, 1), a1 + hstepA, voffA);
            PG8_WAIT_V(8); PG8_WAIT_L(0); PG8_BAR; PG8_MMA(0, 0, At, B0); PG8_MMA(0, 1, At, B1); PG8_BAR; PG8_SCHED;
            PG8_LDA(At, 0, 1); PG8_STAGE(PG8_SB(0, 0), b2, voffB); PG8_STAGE(PG8_SB(0, 1), b2 + hstepB, voffB); PG8_STAGE(PG8_SA(0, 0), a2, voffA);
            PG8_WAIT_V(8); PG8_WAIT_L(0); PG8_BAR; PG8_MMA(1, 0, At, B0); PG8_MMA(1, 1, At, B1); PG8_BAR; PG8_SCHED;
            PG8_LDB(B0, 1, 0); PG8_LDB(B1, 1, 1); PG8_SCHED; PG8_LDA(At, 1, 0); PG8_STAGE(PG8_SA(0, 1), a2 + hstepA, voffA);
            PG8_WAIT_V(8); PG8_WAIT_L(0); PG8_BAR; PG8_MMA(0, 0, At, B0); PG8_MMA(0, 1, At, B1); PG8_BAR; PG8_SCHED;
            PG8_LDA(At, 1, 1); PG8_STAGE(PG8_SB(1, 0), b3, voffB); PG8_STAGE(PG8_SB(1, 1), b3 + hstepB, voffB); PG8_STAGE(PG8_SA(1, 0), a3, voffA);
            PG8_WAIT_V(8); PG8_WAIT_L(0); PG8_BAR; PG8_MMA(1, 0, At, B0); PG8_MMA(1, 1, At, B1); PG8_BAR; PG8_SCHED;
            } else {
            PG8_LDB(B0, 0, 0); PG8_SCHED; PG8_LDA(At, 0, 0); PG8_STAGE(PG8_SA(1, 1), a1 + hstepA, voffA);
            PG8_WAIT_L(8); PG8_BAR; PG8_WAIT_L(0); PG8_MMA(0, 0, At, B0); PG8_BAR; PG8_SCHED;
            PG8_LDB(B1, 0, 1); PG8_STAGE(PG8_SB(0, 0), b2, voffB);
            PG8_BAR; PG8_WAIT_L(0); PG8_MMA(0, 1, At, B1); PG8_BAR;
            PG8_LDA(At, 0, 1); PG8_STAGE(PG8_SA(0, 0), a2, voffA);
            PG8_BAR; PG8_WAIT_L(0); PG8_MMA(1, 0, At, B0); PG8_BAR; PG8_SCHED;
            PG8_STAGE(PG8_SB(0, 1), b2 + hstepB, voffB);
            PG8_WAIT_V(6); PG8_BAR; PG8_MMA(1, 1, At, B1); PG8_BAR;
            PG8_LDB(B0, 1, 0); PG8_SCHED; PG8_LDA(At, 1, 0); PG8_STAGE(PG8_SA(0, 1), a2 + hstepA, voffA);
            PG8_WAIT_L(8); PG8_BAR; PG8_WAIT_L(0); PG8_MMA(0, 0, At, B0); PG8_BAR; PG8_SCHED;
            PG8_LDB(B1, 1, 1); PG8_STAGE(PG8_SB(1, 0), b3, voffB);
            PG8_BAR; PG8_WAIT_L(0); PG8_MMA(0, 1, At, B1); PG8_BAR;
            PG8_LDA(At, 1, 1); PG8_STAGE(PG8_SA(1, 0), a3, voffA);
            PG8_BAR; PG8_WAIT_L(0); PG8_MMA(1, 0, At, B0); PG8_BAR; PG8_SCHED;
            PG8_STAGE(PG8_SB(1, 1), b3 + hstepB, voffB);
            PG8_WAIT_V(6); PG8_BAR; PG8_MMA(1, 1, At, B1); PG8_BAR;
            }
        }
        if constexpr (ALIGN_EPI) { if (wr == 0) PG8_BAR; }
        if constexpr (!Epi::AFTER_DRAIN) { E(acc, cur, wr, wc, fr, fq); S.done(cur); }
        if (!has_next) break;
#pragma unroll
        for (int a = 0; a < 2; ++a)
#pragma unroll
            for (int b = 0; b < 2; ++b)
#pragma unroll
                for (int m = 0; m < 4; ++m)
#pragma unroll
                    for (int n = 0; n < 2; ++n) acc[a][b][m][n] = (f32x4){0.f, 0.f, 0.f, 0.f};
        cur = nxt; cA = nA; cB = nB; ++ui;
        if constexpr (ALIGN_EPI) { if (wr == 1) PG8_BAR; }
    }
    PG8_WAIT_V(0);
    if constexpr (!ALIGN_EPI) { if (wr == 0) PG8_BAR; }
    PG8_BAR;
#undef PG8_SA
#undef PG8_SB
#undef PG8_STAGE
#undef PG8_LDA
#undef PG8_LDB
#undef PG8_MMA
#undef PG8_WAIT_V
#undef PG8_WAIT_L
#undef PG8_BAR
#undef PG8_SCHED
}
}

namespace att {
typedef unsigned short bf16;
using bf16x8 = __attribute__((ext_vector_type(8))) short;
using s16x4  = __attribute__((ext_vector_type(4))) short;
using f32x16 = __attribute__((ext_vector_type(16))) float;
using f32x4  = __attribute__((ext_vector_type(4))) float;
using u32x4  = __attribute__((ext_vector_type(4))) unsigned;
constexpr int NW = 8, QBLK = 32, KVBLK = 64, LDX = 1024, SKV = 2304, SQ = 2048, LDO = 1536;
constexpr float SCALE = 0.125f, THR = 8.f;
constexpr int SHM_V = KVBLK * 128 * 2, SHM_K = KVBLK * 128 * 2;
constexpr int OST = 132;
constexpr int LDS_WS_OFF = 2 * 128 * OST * 4;
constexpr int LDS_BYTES = LDS_WS_OFF + NW * 64 * 4;
#define KSWZ(row, colB) ((row) * 256 + ((colB) ^ (((row) & 7) << 4)))
#define SBAR() __builtin_amdgcn_sched_barrier(0)
__device__ __forceinline__ int crow(int r, int hi) { return (r & 3) + 8 * (r >> 2) + 4 * hi; }
__device__ __forceinline__ unsigned cvtpk(float lo, float hi) { unsigned r; asm volatile("v_cvt_pk_bf16_f32 %0, %1, %2" : "=v"(r) : "v"(lo), "v"(hi)); return r; }
__device__ __forceinline__ bf16x8 ld8(const bf16* p) { return *reinterpret_cast<const bf16x8*>(p); }

__device__ __forceinline__ void partialSM(f32x16& p0, f32x16& p1, float& m_reg, float& mn, float& alpha, bool& resc) {
  constexpr float C = SCALE * 1.4426950408889634f;
  float pmax = p0[0];
#pragma unroll
  for (int r = 1; r < 16; ++r) pmax = fmaxf(pmax, p0[r]);
#pragma unroll
  for (int r = 0; r < 16; ++r) pmax = fmaxf(pmax, p1[r]);
  { auto rr = __builtin_amdgcn_permlane32_swap(__float_as_uint(pmax), __float_as_uint(pmax), false, false);
    pmax = fmaxf(__uint_as_float(rr[0]), __uint_as_float(rr[1])); }
  if (__builtin_expect(__all(pmax - m_reg <= THR / SCALE), 1)) { mn = m_reg; alpha = 1.f; resc = false; }
  else { mn = fmaxf(m_reg, pmax); alpha = __builtin_amdgcn_exp2f((m_reg - mn) * C); m_reg = mn; resc = true; }
  float mnC = -mn * C;
#pragma unroll
  for (int r = 0; r < 16; ++r) p0[r] = fmaf(p0[r], C, mnC);
#pragma unroll
  for (int r = 0; r < 16; ++r) p1[r] = fmaf(p1[r], C, mnC);
#pragma unroll
  for (int r = 0; r < 16; ++r) p0[r] = __builtin_amdgcn_exp2f(p0[r]);
}
__device__ __forceinline__ void finishSM(f32x16& p0, f32x16& p1, float alpha, float& l_reg, bf16x8& pa0, bf16x8& pa1, bf16x8& pa2, bf16x8& pa3) {
#pragma unroll
  for (int r = 0; r < 16; ++r) p1[r] = __builtin_amdgcn_exp2f(p1[r]);
  float ps = 0;
#pragma unroll
  for (int r = 0; r < 16; ++r) ps += p0[r];
#pragma unroll
  for (int r = 0; r < 16; ++r) ps += p1[r];
  { auto rr = __builtin_amdgcn_permlane32_swap(__float_as_uint(ps), __float_as_uint(ps), false, false);
    ps = __uint_as_float(rr[0]) + __uint_as_float(rr[1]); }
  l_reg = l_reg * alpha + ps;
#define PK4(P, BASE, OUT) do { unsigned a0 = cvtpk(P[BASE + 0], P[BASE + 1]), a1 = cvtpk(P[BASE + 2], P[BASE + 3]);   \
    unsigned b0 = cvtpk(P[BASE + 4], P[BASE + 5]), b1 = cvtpk(P[BASE + 6], P[BASE + 7]);                              \
    auto r0 = __builtin_amdgcn_permlane32_swap(a0, b0, false, false); auto r1 = __builtin_amdgcn_permlane32_swap(a1, b1, false, false); \
    u32x4 w = {r0[0], r1[0], r0[1], r1[1]}; OUT = *reinterpret_cast<bf16x8*>(&w); } while (0)
  PK4(p0, 0, pa0); PK4(p0, 8, pa1); PK4(p1, 0, pa2); PK4(p1, 8, pa3);
#undef PK4
}
__device__ __forceinline__ void qkt(f32x16& p0, f32x16& p1, const bf16* Ks, const bf16x8* qr, int r32, int hi, int comp) {
  p0 = f32x16{}; p1 = f32x16{};
#pragma unroll
  for (int d0 = 0; d0 < 4; ++d0) { int cb = (comp * 64 + d0 * 16 + hi * 8) * 2;
    bf16x8 b0 = *reinterpret_cast<const bf16x8*>((const char*)Ks + KSWZ(r32, cb));
    bf16x8 b1 = *reinterpret_cast<const bf16x8*>((const char*)Ks + KSWZ(32 + r32, cb));
    p0 = __builtin_amdgcn_mfma_f32_32x32x16_bf16(b0, qr[d0], p0, 0, 0, 0);
    p1 = __builtin_amdgcn_mfma_f32_32x32x16_bf16(b1, qr[d0], p1, 0, 0, 0); }
}
__device__ __forceinline__ int v_st(int k, int c) { const int kk = (k & ~0xC) | ((k & 4) << 1) | ((k & 8) >> 1); return ((kk >> 3) * 4 + (c >> 5)) * 512 + ((kk & 7) * 32 + (c & 31)) * 2; }
__device__ __forceinline__ int v_rd_base(int lane) { return ((lane & 3) << 3) | (((lane >> 2) & 3) << 6) | (((lane >> 4) & 1) << 5) | (((lane >> 5) & 1) << 8); }
constexpr int v_rd_off(int d0, int ks, int half) { return d0 * 512 + ks * 4096 + half * 2048; }
template <int OFF> __device__ __forceinline__ s16x4 tr_read(int vb) {
  s16x4 r; asm volatile("ds_read_b64_tr_b16 %0, %1 offset:%2" : "=&v"(r) : "v"(vb), "i"(OFF) : "memory"); return r;
}
template <int D0> __device__ __forceinline__ void pv_one(f32x16& od, int vb, bf16x8 pa0, bf16x8 pa1, bf16x8 pa2, bf16x8 pa3) {
  const s16x4 l0 = tr_read<v_rd_off(D0, 0, 0)>(vb), h0 = tr_read<v_rd_off(D0, 0, 1)>(vb), l1 = tr_read<v_rd_off(D0, 1, 0)>(vb), h1 = tr_read<v_rd_off(D0, 1, 1)>(vb);
  const s16x4 l2 = tr_read<v_rd_off(D0, 2, 0)>(vb), h2 = tr_read<v_rd_off(D0, 2, 1)>(vb), l3 = tr_read<v_rd_off(D0, 3, 0)>(vb), h3 = tr_read<v_rd_off(D0, 3, 1)>(vb);
  asm volatile("s_waitcnt lgkmcnt(0)" ::: "memory"); SBAR();
#define PK(L, H) (bf16x8){L[0], L[1], L[2], L[3], H[0], H[1], H[2], H[3]}
  od = __builtin_amdgcn_mfma_f32_32x32x16_bf16(pa0, PK(l0, h0), od, 0, 0, 0);
  od = __builtin_amdgcn_mfma_f32_32x32x16_bf16(pa1, PK(l1, h1), od, 0, 0, 0);
  od = __builtin_amdgcn_mfma_f32_32x32x16_bf16(pa2, PK(l2, h2), od, 0, 0, 0);
  od = __builtin_amdgcn_mfma_f32_32x32x16_bf16(pa3, PK(l3, h3), od, 0, 0, 0);
#undef PK
}
__device__ __forceinline__ void pv_d0(f32x16* o, int vb, bf16x8 pa0, bf16x8 pa1, bf16x8 pa2, bf16x8 pa3) {
  pv_one<0>(o[0], vb, pa0, pa1, pa2, pa3); pv_one<1>(o[1], vb, pa0, pa1, pa2, pa3); pv_one<2>(o[2], vb, pa0, pa1, pa2, pa3); pv_one<3>(o[3], vb, pa0, pa1, pa2, pa3);
}

__device__ __forceinline__ void diff_attn_unit(const bf16* __restrict__ Qb, const bf16* __restrict__ Kh, const bf16* __restrict__ Vh, bf16* __restrict__ Ob,
                                               const float* __restrict__ gsub, float lam, float osc, char* lds) {
  const int tid = threadIdx.x, wid = tid >> 6, lane = tid & 63, r32 = lane & 31, hi = lane >> 5;
  const int comp = wid >> 2, grp = wid & 3;
  bf16* V_lds = (bf16*)lds; bf16* K_lds = (bf16*)(lds + 3 * SHM_V);
  float* ws = (float*)(lds + LDS_WS_OFF) + wid * 64; float* li_l = ws; float* al_l = ws + 32;
  float m_reg = -1e30f, l_reg = 0; f32x16 o[4] = {}; bf16x8 qr[4];
  const bf16* Qw = Qb + (long)(grp * QBLK + r32) * LDX + comp * 64 + hi * 8;
#pragma unroll
  for (int d0 = 0; d0 < 4; ++d0) qr[d0] = ld8(Qw + d0 * 16);
  typedef __attribute__((address_space(3))) unsigned lds_u32;
  __attribute__((address_space(3))) char* lds3 = (__attribute__((address_space(3))) char*)lds;
  const int vb0 = (int)(uintptr_t)V_lds + v_rd_base(lane);
  int koff[2], voff[2];
#pragma unroll
  for (int i = 0; i < 2; ++i) { const int row = 32 * i + 4 * wid + (lane >> 4), ch = (lane & 15) ^ (row & 7); koff[i] = row * LDX + ch * 8;
    const int st = 2 * (2 * wid + i) + (lane >> 5), kk = (st >> 2) * 8 + ((lane & 31) >> 2), c = (st & 3) * 32 + (lane & 3) * 8, k = (kk & ~0xC) | ((kk & 4) << 1) | ((kk & 8) >> 1);
    voff[i] = k * LDX + c; }
  const int kdst = 3 * SHM_V + 4 * wid * 256, vdst = 2 * wid * 1024;
#define DMAK(k0, slot) do { _Pragma("unroll") for (int i_ = 0; i_ < 2; ++i_) __builtin_amdgcn_global_load_lds((const unsigned*)(Kh + (long)(k0) * LDX + koff[i_]), (lds_u32*)(lds3 + kdst + (slot) * SHM_K + i_ * 8192), 16, 0, 0); } while (0)
#define DMAV(k0, soff) do { _Pragma("unroll") for (int i_ = 0; i_ < 2; ++i_) __builtin_amdgcn_global_load_lds((const unsigned*)(Vh + (long)(k0) * LDX + voff[i_]), (lds_u32*)(lds3 + vdst + (soff) + i_ * 1024), 16, 0, 0); } while (0)
#define VMW0() asm volatile("s_waitcnt vmcnt(0)" ::: "memory")
#define RESC(a) do { if (rs_) { if (hi == 0) al_l[r32] = (a); asm volatile("s_waitcnt lgkmcnt(0)" ::: "memory"); \
    _Pragma("unroll") for (int d = 0; d < 4; ++d) _Pragma("unroll") for (int r = 0; r < 16; ++r) o[d][r] *= al_l[crow(r, hi)]; } } while (0)
  bool rs_ = false;
  f32x16 pA0, pA1, pB0, pB1; float mnA, mnB, alA, alB; bf16x8 pa0, pa1, pa2, pa3; constexpr int NT = SKV / KVBLK;
  int vw = SHM_V, va = 0, vbb = 2 * SHM_V;
#define BARSTUFF(j) do { VMW0(); __syncthreads(); \
    if ((j) + 1 < NT) DMAK(((j) + 1) * KVBLK, ((j) + 1) & 1); DMAV((j) * KVBLK, vw); } while (0)
#define ROTV() do { vbb = va; va = vw; vw = (vw == 2 * SHM_V) ? 0 : vw + SHM_V; } while (0)
#define XS(j, C0, C1, P0, P1, ALP) do { qkt(C0, C1, (bf16*)((char*)K_lds + ((j) & 1) * SHM_K), qr, r32, hi, comp); finishSM(P0, P1, ALP, l_reg, pa0, pa1, pa2, pa3); SBAR(); } while (0)
#define YS(C0, C1, MNC, ALC, VOFF) do { pv_d0(o, vb0 + (VOFF), pa0, pa1, pa2, pa3); partialSM(C0, C1, m_reg, MNC, ALC, rs_); RESC(ALC); } while (0)
  DMAK(0, 0); DMAV(0, 0); VMW0(); __syncthreads();
  DMAK(KVBLK, 1);
  if (comp == 0) {
    SBAR(); qkt(pA0, pA1, K_lds, qr, r32, hi, comp); partialSM(pA0, pA1, m_reg, mnA, alA, rs_);
    for (int j = 1; j + 1 < NT; j += 2) {
      BARSTUFF(j);     XS(j, pB0, pB1, pA0, pA1, alA);     YS(pB0, pB1, mnB, alB, va); ROTV();
      BARSTUFF(j + 1); XS(j + 1, pA0, pA1, pB0, pB1, alB); YS(pA0, pA1, mnA, alA, va); ROTV();
    }
    BARSTUFF(NT - 1); XS(NT - 1, pB0, pB1, pA0, pA1, alA); YS(pB0, pB1, mnB, alB, va); ROTV();
    VMW0(); __syncthreads();
    finishSM(pB0, pB1, alB, l_reg, pa0, pa1, pa2, pa3); SBAR();
    pv_d0(o, vb0 + va, pa0, pa1, pa2, pa3);
  } else {
    SBAR(); qkt(pA0, pA1, K_lds, qr, r32, hi, comp);
    BARSTUFF(1); partialSM(pA0, pA1, m_reg, mnA, alA, rs_); XS(1, pB0, pB1, pA0, pA1, alA); ROTV();
    for (int j = 2; j + 1 < NT; j += 2) {
      BARSTUFF(j);     YS(pB0, pB1, mnB, alB, vbb); XS(j, pA0, pA1, pB0, pB1, alB);     ROTV();
      BARSTUFF(j + 1); YS(pA0, pA1, mnA, alA, vbb); XS(j + 1, pB0, pB1, pA0, pA1, alA); ROTV();
    }
    VMW0(); __syncthreads();
    YS(pB0, pB1, mnB, alB, vbb);
    finishSM(pB0, pB1, alB, l_reg, pa0, pa1, pa2, pa3); SBAR();
    pv_d0(o, vb0 + va, pa0, pa1, pa2, pa3);
  }
#undef BARSTUFF
#undef ROTV
#undef XS
#undef YS
  if (hi == 0) li_l[r32] = l_reg; asm volatile("s_waitcnt lgkmcnt(0)" ::: "memory");
  float rli[16];
  const float sgn = comp ? -lam : 1.f;
#pragma unroll
  for (int r = 0; r < 16; ++r) rli[r] = __builtin_amdgcn_rcpf(li_l[crow(r, hi)]) * sgn;
  __syncthreads();
  float* stg = (float*)lds + comp * (128 * OST);
#pragma unroll
  for (int r = 0; r < 16; ++r) { const int orow = grp * QBLK + crow(r, hi);
#pragma unroll
    for (int d0 = 0; d0 < 4; ++d0) stg[orow * OST + d0 * 32 + r32] = o[d0][r] * rli[r]; }
  __syncthreads();
  { const int row = tid >> 2, q4 = tid & 3; const float* s0 = (const float*)lds + row * OST + q4 * 32; const float* s1 = s0 + 128 * OST;
    f32x4 v[8]; float ss = 0.f;
#pragma unroll
    for (int i = 0; i < 8; ++i) { v[i] = *(const f32x4*)(s0 + 4 * i) + *(const f32x4*)(s1 + 4 * i); ss += (v[i][0] * v[i][0] + v[i][1] * v[i][1]) + (v[i][2] * v[i][2] + v[i][3] * v[i][3]); }
    ss += __shfl_xor(ss, 1); ss += __shfl_xor(ss, 2);
    const float rstd = osc * __builtin_amdgcn_rsqf(ss * (1.f / 128.f) + 1e-6f);
    bf16* orow = Ob + (long)row * LDO + q4 * 32;
#pragma unroll
    for (int i = 0; i < 4; ++i) { const f32x4 g0 = *(const f32x4*)(gsub + q4 * 32 + 8 * i), g1 = *(const f32x4*)(gsub + q4 * 32 + 8 * i + 4);
      const f32x4 a = v[2 * i] * g0 * rstd, b = v[2 * i + 1] * g1 * rstd;
      u32x4 w = {cvtpk(a[0], a[1]), cvtpk(a[2], a[3]), cvtpk(b[0], b[1]), cvtpk(b[2], b[3])};
      *(u32x4*)(orow + 8 * i) = w; } }
  __syncthreads();
#undef DMAK
#undef DMAV
#undef VMW0
#undef RESC
}
#undef SBAR
}


#define XB_TMO      128
#define XB_XCNT(j)  (256  + 64 * (j))
#define XB_XSUB(j)  (1280 + 64 * (j))
#define XB_XGEN(j)  (2304 + 64 * (j))
#define XB_TOP      3328
#define XB_TOPGEN   3392
#define XCD_BAR_WORDS 3456
#define XB_SPIN_CAP (1u << 18)
#define XLAS __attribute__((address_space(3)))
__device__ __forceinline__ unsigned xb_ld(unsigned* p)              { return __hip_atomic_load(p, __ATOMIC_RELAXED, __HIP_MEMORY_SCOPE_AGENT); }
__device__ __forceinline__ unsigned xb_add(unsigned* p, unsigned v) { return __hip_atomic_fetch_add(p, v, __ATOMIC_RELAXED, __HIP_MEMORY_SCOPE_AGENT); }
__device__ __forceinline__ unsigned xb_xcc_id() { return (unsigned)__builtin_amdgcn_s_getreg((3 << 11) | 20) & 0xFu; }
#define XB_SPIN(cond, bar) do { unsigned _sp = 0; while (cond) { __builtin_amdgcn_s_sleep(1); \
    if ((++_sp & 255u) == 0u) { if (xb_ld(&(bar)[XB_TMO])) break; if (_sp > XB_SPIN_CAP) { atomicAdd(&(bar)[XB_TMO], 1u); break; } } } } while (0)
struct XcdBarrier { unsigned* bar; unsigned x; volatile XLAS unsigned* st; };
__device__ __forceinline__ XcdBarrier xcd_barrier_post(unsigned* bar, volatile XLAS unsigned* st) {
    XcdBarrier b; b.bar = bar; b.x = xb_xcc_id(); b.st = st;
    if (threadIdx.x == 0) (void)xb_add(&bar[XB_XCNT(b.x)], 1u);
    return b;
}
__device__ __forceinline__ void xcd_barrier_complete(unsigned* bar, unsigned x, unsigned& nloc, unsigned& nx) {
    const unsigned G = gridDim.x * gridDim.y * gridDim.z;
    unsigned sum, cnt, mine, sp = 0u;
    for (;;) {
        sum = 0u; cnt = 0u; mine = 0u;
#pragma unroll
        for (unsigned j = 0; j < 16; ++j) { const unsigned c = xb_ld(&bar[XB_XCNT(j)]); sum += c; cnt += (c > 0u) ? 1u : 0u; mine = (j == x) ? c : mine; }
        if (sum == G) break;
        __builtin_amdgcn_s_sleep(1);
        if ((++sp & 255u) == 0u) { if (xb_ld(&bar[XB_TMO])) break; if (sp > XB_SPIN_CAP) { atomicAdd(&bar[XB_TMO], 1u); break; } }
    }
    nloc = mine > 0u ? mine : 1u; nx = cnt > 0u ? cnt : 1u;
}
__device__ __forceinline__ void xcd_barrier(const XcdBarrier& b) {
    asm volatile("s_waitcnt vmcnt(0)" ::: "memory");
    __syncthreads();
    if (threadIdx.x == 0) {
        unsigned* bar = b.bar;
        __builtin_amdgcn_s_waitcnt(0);
        unsigned nloc = b.st[0], nx = b.st[1];
        if (nloc == 0u) { xcd_barrier_complete(bar, b.x, nloc, nx); b.st[0] = nloc; b.st[1] = nx; }
        const unsigned old = xb_add(&bar[XB_XSUB(b.x)], 1u);
        const unsigned gen = old / nloc;
        if (old + 1u == (gen + 1u) * nloc) {
            __builtin_amdgcn_fence(__ATOMIC_RELEASE, "agent");
            asm volatile("s_waitcnt vmcnt(0)" ::: "memory");
            const unsigned og = xb_add(&bar[XB_TOP], 1u);
            const unsigned tg = og / nx;
            if (og + 1u == (tg + 1u) * nx) xb_add(&bar[XB_TOPGEN], 1u);
            else XB_SPIN(xb_ld(&bar[XB_TOPGEN]) == tg, bar);
            __builtin_amdgcn_fence(__ATOMIC_ACQUIRE, "agent");
            xb_add(&bar[XB_XGEN(b.x)], 1u);
            asm volatile("s_waitcnt vmcnt(0)" ::: "memory");
        } else {
            XB_SPIN(xb_ld(&bar[XB_XGEN(b.x)]) == gen, bar);
            __builtin_amdgcn_fence(__ATOMIC_ACQUIRE, "agent");
            asm volatile("s_waitcnt vmcnt(0)" ::: "memory");
        }
    }
    __syncthreads();
}

typedef unsigned short bf16;
typedef float f32x4 __attribute__((ext_vector_type(4)));
typedef unsigned v4u __attribute__((ext_vector_type(4)));
typedef unsigned v2u __attribute__((ext_vector_type(2)));
#define LAS __attribute__((address_space(3)))
constexpr int NWAVES = 8, NTHR = 512;
constexpr int DM = 1024, NB = 16, SEQ = 2048, CTX = 256, DFF = 2816, INC = 5632, NMOD = 9;
constexpr int MLAT = NB * SEQ, MCTX = NB * CTX, MALL = MLAT + MCTX;
constexpr int KM = 1536;
constexpr int LDS_BYTES = 139264;
constexpr int LDS_MISC_OFF = 138240;
static_assert(att::LDS_BYTES <= LDS_MISC_OFF && pg8::STAGE_BYTES <= LDS_MISC_OFF && LDS_MISC_OFF + 16 <= LDS_BYTES, "LDS map");

struct Args { const float* in[21]; float* out; unsigned char* ws; int ph_lo, ph_hi; };

__device__ __forceinline__ unsigned f2bf(float f) { unsigned u = __builtin_bit_cast(unsigned, f); return (u + 0x7fffu + ((u >> 16) & 1u)) >> 16; }
__device__ __forceinline__ unsigned pk2(float lo, float hi) { return f2bf(lo) | (f2bf(hi) << 16); }
__device__ __forceinline__ float wave_sum(float v) {
#pragma unroll
    for (int o = 1; o < 64; o <<= 1) v += __shfl_xor(v, o);
    return v;
}
__device__ __forceinline__ int permq(int o) { return 8 * ((o >> 2) & 3) + 4 * (o >> 4) + (o & 3); }
__device__ __forceinline__ void transpose_item(const float* W, int N, bf16* WT, int ldt, int kofs, int k0, int n0, int drow0, LAS float* scr, int lane, bool qk = false) {
    { f32x4 v[8];
#pragma unroll
      for (int i = 0; i < 8; ++i) v[i] = *(const f32x4*)(W + (size_t)(k0 + 8 * i + (lane >> 3)) * N + n0 + 4 * (lane & 7));
#pragma unroll
      for (int i = 0; i < 8; ++i) { LAS float* d = scr + (8 * i + (lane >> 3)) * 33 + 4 * (lane & 7); d[0] = v[i].x; d[1] = v[i].y; d[2] = v[i].z; d[3] = v[i].w; } }
    asm volatile("s_waitcnt lgkmcnt(0)" ::: "memory");
    const int c = lane & 7;
#pragma unroll
    for (int j = 0; j < 4; ++j) { const int n = (lane >> 3) + 8 * j; const LAS float* s = scr + (8 * c) * 33 + n;
        v4u o; o.x = pk2(s[0 * 33], s[1 * 33]); o.y = pk2(s[2 * 33], s[3 * 33]); o.z = pk2(s[4 * 33], s[5 * 33]); o.w = pk2(s[6 * 33], s[7 * 33]);
        *(v4u*)(WT + (size_t)(drow0 + (qk ? permq(n) : n)) * ldt + kofs + k0 + 8 * c) = o; }
    asm volatile("s_waitcnt lgkmcnt(0)" ::: "memory");
}
__device__ __forceinline__ void adaln_row(const float* xrow, const float* g, const float* shift, const float* scale, bf16* orow, int lane) {
    const f32x4* xr = (const f32x4*)xrow + lane;
    f32x4 v[4]; float s2 = 0.f;
#pragma unroll
    for (int j = 0; j < 4; ++j) { v[j] = xr[64 * j]; s2 += (v[j].x * v[j].x + v[j].y * v[j].y) + (v[j].z * v[j].z + v[j].w * v[j].w); }
    const float rstd = 1.0f / sqrtf(wave_sum(s2) * (1.f / DM) + 1e-6f);
    unsigned long long* o8 = (unsigned long long*)orow + lane;
#pragma unroll
    for (int j = 0; j < 4; ++j) { const f32x4 gg = ((const f32x4*)g)[lane + 64 * j], sh = ((const f32x4*)shift)[lane + 64 * j], sc = ((const f32x4*)scale)[lane + 64 * j];
        const f32x4 h = v[j] * rstd * gg * (sc + 1.0f) + sh;
        o8[64 * j] = (unsigned long long)pk2(h.x, h.y) | ((unsigned long long)pk2(h.z, h.w) << 32); }
}


__device__ __forceinline__ void gemv17_item(LAS float* ldsf, const float* v0, int vstride, const float* v16, bool silu, const float* W, int ldw, int ncol0,
                                            const float* addb, float* outp, int out_ld, int ocol0, int nrows, int wave, int lane, int tid, bool qk = false) {
    LAS float* sw = ldsf + wave * (17 * 128);
    LAS float* red = ldsf + 8 * 17 * 128;
    const int kbase = wave * 128, n = ncol0 + lane;
    { float cv[34];
#pragma unroll
      for (int i = 0; i < 34; ++i) { const int idx = lane + 64 * i, b = idx >> 7, kk = idx & 127; cv[i] = (b < 16) ? v0[(size_t)b * vstride + kbase + kk] : v16[kbase + kk]; }
#pragma unroll
      for (int i = 0; i < 34; ++i) sw[lane + 64 * i] = silu ? cv[i] / (1.0f + __expf(-cv[i])) : cv[i]; }
    asm volatile("s_waitcnt lgkmcnt(0)" ::: "memory");
    float a[17];
#pragma unroll
    for (int b = 0; b < 17; ++b) a[b] = 0.f;
    for (int k0 = 0; k0 < 128; k0 += 16) { float wv[16];
#pragma unroll
        for (int kk = 0; kk < 16; ++kk) wv[kk] = W[(size_t)(kbase + k0 + kk) * ldw + n];
#pragma unroll
        for (int kk = 0; kk < 16; ++kk)
#pragma unroll
            for (int b = 0; b < 17; ++b) a[b] += sw[b * 128 + k0 + kk] * wv[kk]; }
#pragma unroll
    for (int b = 0; b < 17; ++b) red[(wave * 17 + b) * 64 + lane] = a[b];
    __syncthreads();
    for (int idx = tid; idx < nrows * 64; idx += NTHR) { const int b = idx >> 6, l = idx & 63; float sacc = 0.f;
#pragma unroll
        for (int w = 0; w < 8; ++w) sacc += red[(w * 17 + b) * 64 + l];
        outp[(size_t)b * out_ld + ocol0 + (qk ? ((l & 32) + permq(l & 31)) : l)] = sacc + (addb ? addb[ncol0 + l] : 0.f); }
    __syncthreads();
}

__global__ void __launch_bounds__(NTHR) fwd_kernel(Args args) {
    extern __shared__ __attribute__((aligned(16))) unsigned char lds[];
    cg::grid_group grid = cg::this_grid();
    const int tid = threadIdx.x, lane = tid & 63, wave = __builtin_amdgcn_readfirstlane(tid >> 6);
    const int G = gridDim.x, bx = blockIdx.x;
    const int gw = bx * NWAVES + wave, NGW = G * NWAVES;
    unsigned char* ws = args.ws;
    const float* x = args.in[0]; const float* cvec = args.in[1]; const float* ctx = args.in[2]; const float* c_ctx = args.in[3];
    const float* w_mod = args.in[4]; const float* b_mod = args.in[5]; const float* g_norm = args.in[6]; const float* w_gu = args.in[7];
    const float* w_down = args.in[8]; const float* w_in = args.in[9]; const float* lq1 = args.in[10]; const float* lk1 = args.in[11];
    const float* lq2 = args.in[12]; const float* lk2 = args.in[13]; const float* g_subln = args.in[14]; const float* w_pool = args.in[15];
    const float* pool_scale = args.in[16]; const float* w_ba = args.in[17]; const float* w_bp = args.in[18]; const float* w_out = args.in[19];
    const float* g_final = args.in[20];
    float* out = args.out;
    float* mod = (float*)(ws + WS_MOD); float* cosT = (float*)(ws + WS_COS); float* sinT = (float*)(ws + WS_SIN); float* lamp = (float*)(ws + WS_LAM);
    bf16* Wgu1 = (bf16*)(ws + WS_WGU1); bf16* Wgu2 = (bf16*)(ws + WS_WGU2); bf16* Wd1 = (bf16*)(ws + WS_WD1); bf16* Wd2 = (bf16*)(ws + WS_WD2);
    bf16* Win = (bf16*)(ws + WS_WIN); bf16* Wm = (bf16*)(ws + WS_WM); bf16* Wout = (bf16*)(ws + WS_WOUT);
    bf16* Abuf = (bf16*)(ws + WS_ABUF); bf16* Amerge = (bf16*)(ws + WS_AMERGE); float* lat1 = (float*)(ws + WS_LAT1);
    bf16* Qb = (bf16*)(ws + WS_Q); bf16* Kb = (bf16*)(ws + WS_K); bf16* Vb = (bf16*)(ws + WS_V); bf16* Ub = (bf16*)(ws + WS_U);
    bf16* Hb = (bf16*)(ws + WS_H); bf16* Yb = (bf16*)(ws + WS_Y); bf16* Gb = (bf16*)out;
    float* rss2 = (float*)(ws + WS_RSS2); float* rss3 = (float*)(ws + WS_RSS3); float* bias2 = (float*)(ws + WS_BIAS2); float* bias3 = (float*)(ws + WS_BIAS3);
    const int lo = args.ph_lo, hi = args.ph_hi;
#define IN(k) (lo <= (k) && (k) < hi)
#define SEAM(k) do { if (IN(k) && hi > (k) + 1) { xcd_barrier(xbar); } } while (0)
    volatile XLAS unsigned* misc = (volatile XLAS unsigned*)((XLAS unsigned char*)lds + LDS_MISC_OFF);
    if (tid < 4) misc[tid] = 0u;
    __syncthreads();
    XcdBarrier xbar; xbar.bar = (unsigned*)(ws + WS_BAR); xbar.x = 0; xbar.st = misc;
    if (hi - lo > 1) {
        for (int i = bx * NTHR + tid; i < XCD_BAR_WORDS; i += G * NTHR) __hip_atomic_store((unsigned*)(ws + WS_BAR) + i, 0u, __ATOMIC_RELAXED, __HIP_MEMORY_SCOPE_AGENT);
        asm volatile("s_waitcnt vmcnt(0)" ::: "memory");
        grid.sync();
        xbar = xcd_barrier_post((unsigned*)(ws + WS_BAR), misc); }
    PG8_LAS unsigned char* glds = (PG8_LAS unsigned char*)lds;

    if (IN(0)) {
        if (bx < 144) gemv17_item((LAS float*)lds, cvec, DM, c_ctx, true, w_mod, NMOD * DM, bx * 64, b_mod, mod, NMOD * DM, bx * 64, 17, wave, lane, tid);
        else { for (int i = (bx - 144) * NTHR + tid; i < MALL + MLAT; i += (G - 144) * NTHR) { if (i < MALL) rss2[i] = 0.f; else rss3[i - MALL] = 0.f; }
            LAS float* scr = (LAS float*)lds + wave * 4096;
            for (int it = (bx - 144) * NWAVES + wave; it < 1792; it += (G - 144) * NWAVES) { const int kb = it / 176, nb = it % 176, n0 = nb * 32; const int isb = n0 >= DFF, j = n0 - isb * DFF;
                transpose_item(w_gu, 2 * DFF, Wgu1, DM, 0, kb * 64, n0, (j >> 7) * 256 + isb * 128 + (j & 127), scr, lane); } }
        if (bx == G - 1) {
            for (int idx = tid; idx < 1024; idx += NTHR) { const int pos = idx >> 4, i = idx & 15; const float freq = exp2f(-(float)i * (13.287712379549449f / 16.0f)); const float ang = (float)pos * freq;
                cosT[idx] = __cosf(ang); sinT[idx] = __sinf(ang); }
            if (wave == 0) { const float s1 = wave_sum(lq1[lane] * lk1[lane]), s2 = wave_sum(lq2[lane] * lk2[lane]); if (lane == 0) lamp[0] = __expf(s1) - __expf(s2) + 0.2f; }
        }
    }
    SEAM(0);
    if (IN(1)) {
        {
            f32x4 v[4], vn[4];
            auto rowsrc = [&](int r) -> const float* { return (r >= MLAT) ? ctx + (size_t)(r - MLAT) * DM : x + (size_t)r * DM; };
            int r = gw;
            if (r < MALL) {
#pragma unroll
                for (int j = 0; j < 4; ++j) v[j] = ((const f32x4*)rowsrc(r))[lane + 64 * j]; }
            for (; r < MALL; r += NGW) {
                const int rn = r + NGW; const bool hasn = rn < MALL;
                if (hasn) {
#pragma unroll
                    for (int j = 0; j < 4; ++j) vn[j] = ((const f32x4*)rowsrc(rn))[lane + 64 * j]; }
                const int brow = (r >= MLAT) ? 16 : (r >> 11); const float* mr = mod + (size_t)brow * (NMOD * DM);
                f32x4 gg[4], sh[4], sc[4];
#pragma unroll
                for (int j = 0; j < 4; ++j) { gg[j] = ((const f32x4*)g_norm)[lane + 64 * j]; sh[j] = ((const f32x4*)mr)[lane + 64 * j]; sc[j] = ((const f32x4*)(mr + DM))[lane + 64 * j]; }
                float s2 = 0.f;
#pragma unroll
                for (int j = 0; j < 4; ++j) s2 += (v[j].x * v[j].x + v[j].y * v[j].y) + (v[j].z * v[j].z + v[j].w * v[j].w);
                const float rstd = 1.0f / sqrtf(wave_sum(s2) * (1.f / DM) + 1e-6f);
                unsigned long long* o8 = (unsigned long long*)(Abuf + (size_t)r * DM) + lane;
#pragma unroll
                for (int j = 0; j < 4; ++j) { const f32x4 h = v[j] * rstd * gg[j] * (sc[j] + 1.0f) + sh[j];
                    o8[64 * j] = (unsigned long long)pk2(h.x, h.y) | ((unsigned long long)pk2(h.z, h.w) << 32); }
#pragma unroll
                for (int j = 0; j < 4; ++j) v[j] = vn[j];
            }
        }
        LAS float* scr = (LAS float*)lds + wave * 4096;
        constexpr int I_GU = 16 * 176;
        for (int it = 1792 + gw; it < I_GU; it += NGW) {
            const int kb = it / 176, nb = it % 176, n0 = nb * 32; const int isb = n0 >= DFF, j = n0 - isb * DFF;
            transpose_item(w_gu, 2 * DFF, Wgu1, DM, 0, kb * 64, n0, (j >> 7) * 256 + isb * 128 + (j & 127), scr, lane); }
    }
    SEAM(1);
    if (IN(2)) { pg8::Gemm g{Abuf, Wgu1, MALL, 2 * DFF, DM, DM, DM}; pg8::StaticOrder S; S.init(MALL, 2 * DFF, G, bx, WGM_W); pg8::EpiSwiglu<false> E{ws};
        pg8::gemm_phase<pg8::EpiSwiglu<false>, pg8::StaticOrder, true, true>(glds, g, S, E);
        if (bx >= 96) { LAS float* scr = (LAS float*)lds + wave * 4096; constexpr int I_D = 44 * 32;
            for (int it = (bx - 96) * NWAVES + wave; it < I_D; it += (G - 96) * NWAVES) { const int kb = it / 32, nb = it % 32; transpose_item(w_down, DM, Wd1, DFF, 0, kb * 64, nb * 32, nb * 32, scr, lane); } }
    }
    SEAM(2);
    if (IN(3)) { pg8::Gemm g{Hb, Wd1, MALL, DM, DFF, DFF, DFF}; pg8::StaticOrder S; S.init(MALL, DM, G, bx, WGM_N); pg8::EpiResid<true, 2, 4, 1> E{x, ctx, lat1, ws, g_norm + DM};
        pg8::gemm_phase<pg8::EpiResid<true, 2, 4, 1>, pg8::StaticOrder, true, true>(glds, g, S, E);
        if (bx >= 64) {
            LAS float* scr = (LAS float*)lds + wave * 4096;
            constexpr int I_GU = 16 * 176, I_D = 44 * 32, I_SQ = 16 * 32, I_IN = 16 * 176;
            for (int it = (bx - 64) * NWAVES + wave; it < I_IN + I_GU + I_D + 2 * I_SQ; it += (G - 64) * NWAVES) {
                int r = it;
                if (r < I_IN) { const int kb = r / 176, nb = r % 176; transpose_item(w_in, INC, Win, DM, 0, kb * 64, nb * 32, nb * 32, scr, lane, nb < 64); continue; }
                r -= I_IN;
                if (r < I_GU) { const int kb = r / 176, nb = r % 176, n0 = nb * 32; const int isb = n0 >= DFF, j = n0 - isb * DFF;
                    transpose_item(w_gu + (size_t)DM * 2 * DFF, 2 * DFF, Wgu2, DM, 0, kb * 64, n0, (j >> 7) * 256 + isb * 128 + (j & 127), scr, lane); continue; }
                r -= I_GU;
                if (r < I_D) { const int kb = r / 32, nb = r % 32; transpose_item(w_down + (size_t)DFF * DM, DM, Wd2, DFF, 0, kb * 64, nb * 32, nb * 32, scr, lane); continue; }
                r -= I_D;
                if (r < I_SQ) { const int kb = r / 32, nb = r % 32; transpose_item(w_ba, DM, Wm, KM, 0, kb * 64, nb * 32, nb * 32, scr, lane); continue; }
                r -= I_SQ;
                { const int kb = r / 32, nb = r % 32; transpose_item(w_out, DM, Wout, DM, 0, kb * 64, nb * 32, nb * 32, scr, lane); }
            }
            { const int item = (bx - 64) * NTHR + tid;
              if (item < 4 * 16 * 1024) { const int n = item & 1023, ib = (item >> 10) & 15, g = item >> 14;
                float a[8];
#pragma unroll
                for (int ii = 0; ii < 8; ++ii) a[ii] = 0.f;
                for (int j0 = 0; j0 < 128; j0 += 16) { float wv[16];
#pragma unroll
                    for (int jj = 0; jj < 16; ++jj) wv[jj] = pool_scale[g * 128 + j0 + jj] * w_bp[(size_t)(g * 128 + j0 + jj) * DM + n];
#pragma unroll
                    for (int jj = 0; jj < 16; ++jj)
#pragma unroll
                        for (int ii = 0; ii < 8; ++ii) a[ii] += w_pool[(size_t)(g * 128 + ib * 8 + ii) * 128 + j0 + jj] * wv[jj]; }
                v4u o; o.x = pk2(a[0], a[1]); o.y = pk2(a[2], a[3]); o.z = pk2(a[4], a[5]); o.w = pk2(a[6], a[7]);
                *(v4u*)(Wm + (size_t)n * KM + 1024 + g * 128 + ib * 8) = o; } }
            __syncthreads();
            if (bx < 64 + 176) { const int bi = bx - 64, which = bi / 88, it = bi % 88, n0 = it * 64;
                if (which == 0) gemv17_item((LAS float*)lds, mod + 3 * DM, NMOD * DM, mod + (size_t)16 * NMOD * DM + 3 * DM, false, w_in, INC, n0, nullptr, bias2, INC, n0, 17, wave, lane, tid, n0 < 2048);
                else { const int isb = n0 >= DFF, j = n0 - isb * DFF;
                    gemv17_item((LAS float*)lds, mod + 6 * DM, NMOD * DM, mod + (size_t)16 * NMOD * DM + 6 * DM, false, w_gu + (size_t)DM * 2 * DFF, 2 * DFF, n0, nullptr, bias3, INC, (j >> 7) * 256 + isb * 128 + (j & 127), 16, wave, lane, tid); } }
        }
    }
    SEAM(3);
    if (IN(5)) {
        { pg8::Gemm g{Abuf, Win, MLAT, INC, DM, DM, DM}; pg8::StaticOrder S; S.init(MLAT, INC, G, bx, WGM_W); pg8::EpiProj E{ws, Gb, 0};
          pg8::gemm_phase<pg8::EpiProj, pg8::StaticOrder, true, true>(glds, g, S, E); }
        { pg8::Gemm g{Abuf + (size_t)MLAT * DM, Win + (size_t)1024 * DM, MCTX, 2048, DM, DM, DM}; pg8::StaticOrder S; S.init(MCTX, 2048, G, bx, WGM_W); pg8::EpiProj E{ws, Gb, 1};
          pg8::gemm_phase<pg8::EpiProj, pg8::StaticOrder, true, true>(glds, g, S, E); }
    }
    SEAM(5);
    if (IN(6)) {
        for (int r = gw; r < MLAT; r += NGW) { const int t = r & (SEQ - 1); const int g = lane >> 4, hw = 1 << g;
            const bf16* up = Ub + (size_t)r * 512 + lane * 8;
            const int tlo = (t - hw) < 0 ? 0 : (t - hw), thi = (t + hw) > SEQ ? SEQ : (t + hw);
            v4u u[16];
#pragma unroll
            for (int i = 0; i < 16; ++i) { const int tt = t + i - 8; const bool ok = (tt >= tlo) && (tt < thi); u[i] = ok ? *(const v4u*)(up + (ptrdiff_t)(i - 8) * 512) : (v4u){0u, 0u, 0u, 0u}; }
            float a[8];
#pragma unroll
            for (int i = 0; i < 8; ++i) a[i] = 0.f;
#pragma unroll
            for (int i = 0; i < 16; ++i) { a[0] += pg8::bf_lo(u[i].x); a[1] += pg8::bf_hi(u[i].x); a[2] += pg8::bf_lo(u[i].y); a[3] += pg8::bf_hi(u[i].y);
                a[4] += pg8::bf_lo(u[i].z); a[5] += pg8::bf_hi(u[i].z); a[6] += pg8::bf_lo(u[i].w); a[7] += pg8::bf_hi(u[i].w); }
            const float inv = 1.0f / (float)(thi - tlo); const v4u u0 = u[8];
            v4u o; o.x = pk2(a[0] * inv - pg8::bf_lo(u0.x), a[1] * inv - pg8::bf_hi(u0.x)); o.y = pk2(a[2] * inv - pg8::bf_lo(u0.y), a[3] * inv - pg8::bf_hi(u0.y));
            o.z = pk2(a[4] * inv - pg8::bf_lo(u0.z), a[5] * inv - pg8::bf_hi(u0.z)); o.w = pk2(a[6] * inv - pg8::bf_lo(u0.w), a[7] * inv - pg8::bf_hi(u0.w));
            *(v4u*)(Amerge + (size_t)r * KM + 1024 + lane * 8) = o; }
        __syncthreads();
        const float lam = lamp[0];
        const int vcu = (G % 8 == 0) ? (bx % 8) * (G / 8) + bx / 8 : bx;
        for (int un = vcu; un < NB * 8 * 16; un += G) { const int bh = un >> 4, qb = un & 15, b = bh >> 3, h = bh & 7;
            att::diff_attn_unit(Qb + (size_t)(b * SEQ + qb * 128) * DM + h * 128, Kb + (size_t)b * att::SKV * DM + h * 128, Vb + (size_t)b * att::SKV * DM + h * 128,
                                Amerge + (size_t)(b * SEQ + qb * 128) * KM + h * 128, g_subln, lam, 0.8f, (char*)lds); }
    }
    SEAM(6);
    if (IN(7)) {
        { pg8::Gemm g{Amerge, Wm, MLAT, DM, 1024, KM, KM}; pg8::StaticOrder S; S.init(MLAT, DM, G, bx, 4); pg8::EpiMerge<false> E{Gb, Yb};
          pg8::gemm_phase<pg8::EpiMerge<false>, pg8::StaticOrder, true, true>(glds, g, S, E); }
        { pg8::Gemm g{Amerge + 1024, Wm + 1024, MLAT, DM, 512, KM, KM}; pg8::StaticOrder S; S.init(MLAT, DM, G, bx, 4); pg8::EpiMerge<true> E{Gb, Yb};
          pg8::gemm_phase<pg8::EpiMerge<true>, pg8::StaticOrder, true, true>(glds, g, S, E); }
    }
    SEAM(7);
    if (IN(8)) { pg8::Gemm g{Yb, Wout, MLAT, DM, DM, DM, DM}; pg8::StaticOrder S; S.init(MLAT, DM, G, bx, 4); pg8::EpiResid<true, 5, 7, 0> E{lat1, lat1, out, ws, g_norm + 2 * DM};
        pg8::gemm_phase<pg8::EpiResid<true, 5, 7, 0>, pg8::StaticOrder, true, true>(glds, g, S, E); }
    SEAM(8);
    if (IN(10)) { pg8::Gemm g{Abuf, Wgu2, MLAT, 2 * DFF, DM, DM, DM}; pg8::StaticOrder S; S.init(MLAT, 2 * DFF, G, bx, WGM_W); pg8::EpiSwiglu<true> E{ws};
        pg8::gemm_phase<pg8::EpiSwiglu<true>, pg8::StaticOrder, true, true>(glds, g, S, E); }
    SEAM(10);
    if (IN(11)) { pg8::Gemm g{Hb, Wd2, MLAT, DM, DFF, DFF, DFF}; pg8::StaticOrder S; S.init(MLAT, DM, G, bx, WGM_N); pg8::EpiResid<false, 8, 0, 1> E{out, out, out, ws, nullptr};
        pg8::gemm_phase<pg8::EpiResid<false, 8, 0, 1>, pg8::StaticOrder, true, true>(glds, g, S, E); }
    SEAM(11);
    if (IN(12)) {
        f32x4 v[4], vn[4], gf[4];
#pragma unroll
        for (int j = 0; j < 4; ++j) gf[j] = ((const f32x4*)g_final)[lane + 64 * j];
        int r = gw;
        if (r < MLAT) {
#pragma unroll
            for (int j = 0; j < 4; ++j) v[j] = ((const f32x4*)(out + (size_t)r * DM))[lane + 64 * j]; }
        for (; r < MLAT; r += NGW) {
            const int rn = r + NGW;
            if (rn < MLAT) {
#pragma unroll
                for (int j = 0; j < 4; ++j) vn[j] = ((const f32x4*)(out + (size_t)rn * DM))[lane + 64 * j]; }
            float s2 = 0.f;
#pragma unroll
            for (int j = 0; j < 4; ++j) s2 += (v[j].x * v[j].x + v[j].y * v[j].y) + (v[j].z * v[j].z + v[j].w * v[j].w);
            const float rstd = 1.0f / sqrtf(wave_sum(s2) * (1.f / DM) + 1e-6f);
            f32x4* xr = (f32x4*)(out + (size_t)r * DM) + lane;
#pragma unroll
            for (int j = 0; j < 4; ++j) xr[64 * j] = v[j] * rstd * gf[j];
#pragma unroll
            for (int j = 0; j < 4; ++j) v[j] = vn[j];
        }
    }
#undef IN
#undef SEAM
}

extern "C" void kernel_launch(void* const* d_in, const int* in_sizes, int n_in, void* d_out, int out_size, void* d_ws, size_t ws_size, hipStream_t stream) {
    static int grid = 0;
    if (grid == 0) {
        if (n_in != 21 || out_size != MLAT * DM || ws_size < WS_END) { fprintf(stderr, "kernel_launch: unexpected shapes (n_in %d out %d ws %zu)\n", n_in, out_size, ws_size); grid = -1; return; }
        int dev = 0, cus = 0, per_cu = 0;
        hipGetDevice(&dev); hipDeviceGetAttribute(&cus, hipDeviceAttributeMultiprocessorCount, dev);
        if (hipFuncSetAttribute((const void*)fwd_kernel, hipFuncAttributeMaxDynamicSharedMemorySize, LDS_BYTES) != hipSuccess) { fprintf(stderr, "kernel_launch: hipFuncSetAttribute failed\n"); grid = -1; return; }
        if (hipOccupancyMaxActiveBlocksPerMultiprocessor(&per_cu, (const void*)fwd_kernel, NTHR, LDS_BYTES) != hipSuccess || per_cu < 1) { fprintf(stderr, "kernel_launch: occupancy query says %d\n", per_cu); per_cu = 1; }
        (void)hipGetLastError();
        grid = cus * 1;
    }
    if (grid < 0) return;
    Args a{};
    for (int i = 0; i < 21; ++i) a.in[i] = (const float*)d_in[i];
    a.out = (float*)d_out; a.ws = (unsigned char*)d_ws;
#if MK_MULTI
    for (int p = 0; p < 13; ++p) { a.ph_lo = p; a.ph_hi = p + 1; hipLaunchKernelGGL(fwd_kernel, dim3(grid), dim3(NTHR), LDS_BYTES, stream, a); }
#else
    a.ph_lo = 0; a.ph_hi = 13;
    void* kargs[] = {&a};
    hipError_t e = hipLaunchCooperativeKernel((const void*)fwd_kernel, dim3(grid), dim3(NTHR), kargs, LDS_BYTES, stream);
    if (e != hipSuccess) fprintf(stderr, "kernel_launch: cooperative launch failed: %s (grid %d)\n", hipGetErrorString(e), grid);
#endif
}
```
